# Optimizing an MI355X kernel written in HIP

```python
import jax, jax.numpy as jnp
from jax import lax
import numpy as np

D_MODEL = 2048
BATCH = 4
SEQ = 2048
DEPTH = 2

N_MIXERS = 2
N_A_LAYERS = (DEPTH + 1) // 2
N_B_LAYERS = DEPTH // 2
BRANCH_WIDTH = D_MODEL
SGU_CHUNK = 128
SGU_GROUPS = 16
SGU_GROUP_WIDTH = BRANCH_WIDTH // SGU_GROUPS
MOBA_HEADS = 16
MOBA_HEAD_DIM = BRANCH_WIDTH // MOBA_HEADS
MOBA_BLOCK = 256
MOBA_TOP_K = 3
MOBA_Q_CHUNK = 16
PLE_DIM = 256
LN_EPS = 1e-5
DEEPNORM_ALPHA = (2 * DEPTH) ** 0.25
DEEPNORM_BETA = (8 * DEPTH) ** -0.25

kernel_name = "hybrid_sgu_moba_deepnorm_ple"


def layer_norm(x, g, b):
    xf = x.astype(jnp.float32)
    mu = jnp.mean(xf, axis=-1, keepdims=True)
    var = jnp.mean(jnp.square(xf - mu), axis=-1, keepdims=True)
    y = (xf - mu) * lax.rsqrt(var + LN_EPS)
    return (y * g.astype(jnp.float32) + b.astype(jnp.float32)).astype(x.dtype)


def sgu_mixer(x, w_in, v_g, v_b, w_s, b_s):
    B, S, _ = x.shape
    W = BRANCH_WIDTH
    h = x @ w_in
    uv = jax.nn.gelu(h[..., :2 * W])
    z = h[..., 2 * W:]
    u, v = uv[..., :W], uv[..., W:]
    v = layer_norm(v, v_g, v_b)
    nc = S // SGU_CHUNK
    v = v.reshape(B, nc, SGU_CHUNK, SGU_GROUPS, SGU_GROUP_WIDTH)
    causal = jnp.tril(jnp.ones((SGU_CHUNK, SGU_CHUNK), dtype=bool))
    w_causal = jnp.where(causal[None], w_s, jnp.zeros_like(w_s))
    s = jnp.einsum('gts,bnsgc->bntgc', w_causal, v) + b_s.T[None, None, :, :, None]
    s = s.reshape(B, S, W)
    return u * s * jax.nn.silu(z)


def moba_mixer(x, w_in):
    B, S, _ = x.shape
    H, hd, BLK, QC = MOBA_HEADS, MOBA_HEAD_DIM, MOBA_BLOCK, MOBA_Q_CHUNK
    h = x @ w_in
    q, k, v, z = jnp.split(h, 4, axis=-1)

    def heads(t):
        return t.reshape(B, S, H, hd).transpose(0, 2, 1, 3)

    q = heads(q) * (hd ** -0.5)
    k, v = heads(k), heads(v)
    nb = -(-S // BLK)
    pad = ((0, 0), (0, 0), (0, nb * BLK - S), (0, 0))
    k_blocks = jnp.pad(k, pad).reshape(B, H, nb, BLK, hd)
    v_blocks = jnp.pad(v, pad).reshape(B, H, nb, BLK, hd)
    k_mean = jnp.mean(k_blocks, axis=3)
    n_sel = min(MOBA_TOP_K, nb)
    blk_ids = jnp.arange(nb)
    b_ix = jnp.arange(B)[:, None, None, None]
    h_ix = jnp.arange(H)[None, :, None, None]
    neg_inf = jnp.float32(-jnp.inf)

    def chunk(c):
        q0 = c * QC
        qc = lax.dynamic_slice_in_dim(q, q0, QC, axis=2)
        own = q0 // BLK
        gate = jnp.einsum('bhqd,bhnd->bhqn', qc, k_mean).astype(jnp.float32)
        gate = jnp.where((blk_ids < own)[None, None, None, :], gate, neg_inf)
        _, idx = lax.top_k(gate, n_sel)
        slot_valid = jnp.repeat(jnp.arange(n_sel) < own, BLK)
        k_sel = k_blocks[b_ix, h_ix, idx].reshape(B, H, QC, n_sel * BLK, hd)
        v_sel = v_blocks[b_ix, h_ix, idx].reshape(B, H, QC, n_sel * BLK, hd)
        s_sel = jnp.einsum('bhqd,bhqkd->bhqk', qc, k_sel).astype(jnp.float32)
        s_sel = jnp.where(slot_valid[None, None, None, :], s_sel, neg_inf)
        k_own = lax.dynamic_slice_in_dim(k_blocks, own, 1, axis=2)[:, :, 0]
        v_own = lax.dynamic_slice_in_dim(v_blocks, own, 1, axis=2)[:, :, 0]
        s_own = jnp.einsum('bhqd,bhkd->bhqk', qc, k_own).astype(jnp.float32)
        q_pos = q0 + jnp.arange(QC)
        k_pos = own * BLK + jnp.arange(BLK)
        s_own = jnp.where((k_pos[None, :] <= q_pos[:, None])[None, None], s_own, neg_inf)
        probs = jax.nn.softmax(jnp.concatenate([s_sel, s_own], axis=-1), axis=-1).astype(v.dtype)
        o = jnp.einsum('bhqk,bhqkd->bhqd', probs[..., :n_sel * BLK], v_sel)
        o = o + jnp.einsum('bhqk,bhkd->bhqd', probs[..., n_sel * BLK:], v_own)
        return o

    out = lax.map(chunk, jnp.arange(S // QC))
    out = out.transpose(1, 0, 3, 2, 4).reshape(B, S, H * hd)
    return out * jax.nn.silu(z)


def setup_inputs(seed: int = 0) -> dict:
    key = jax.random.key(seed)
    ks = jax.random.split(key, 14)
    D, W = D_MODEL, BRANCH_WIDTH
    f32 = jnp.float32
    x = jax.random.normal(ks[0], (BATCH, SEQ, D), f32)
    p = jax.random.normal(ks[1], (DEPTH, BATCH, SEQ, PLE_DIM), f32)
    w_in_a = jax.random.normal(ks[2], (N_A_LAYERS, D, 3 * W), f32) * D ** -0.5
    sgu_norm_g = 1.0 + 0.05 * jax.random.normal(ks[3], (N_A_LAYERS, W), f32)
    sgu_norm_b = 0.05 * jax.random.normal(ks[4], (N_A_LAYERS, W), f32)
    w_s = jax.random.normal(ks[5], (N_A_LAYERS, SGU_GROUPS, SGU_CHUNK, SGU_CHUNK), f32) * SGU_CHUNK ** -0.5
    b_s = 1.0 + 0.1 * jax.random.normal(ks[6], (N_A_LAYERS, SGU_GROUPS, SGU_CHUNK), f32)
    w_in_b = jax.random.normal(ks[7], (N_B_LAYERS, D, 4 * W), f32) * D ** -0.5
    w_out = jax.random.normal(ks[8], (DEPTH, W, D), f32) * (W ** -0.5 * DEEPNORM_BETA)
    ln_g = 1.0 + 0.05 * jax.random.normal(ks[9], (DEPTH, D), f32)
    ln_b = 0.05 * jax.random.normal(ks[10], (DEPTH, D), f32)
    w_ple_gate = jax.random.normal(ks[11], (DEPTH, D, D), f32) * D ** -0.5
    w_ple_proj = jax.random.normal(ks[12], (DEPTH, PLE_DIM, D), f32) * PLE_DIM ** -0.5
    return {"x": x, "p": p, "w_in_a": w_in_a, "sgu_norm_g": sgu_norm_g,
            "sgu_norm_b": sgu_norm_b, "w_s": w_s, "b_s": b_s, "w_in_b": w_in_b,
            "w_out": w_out, "ln_g": ln_g, "ln_b": ln_b,
            "w_ple_gate": w_ple_gate, "w_ple_proj": w_ple_proj}


def reference(x, p, w_in_a, sgu_norm_g, sgu_norm_b, w_s, b_s, w_in_b,
              w_out, ln_g, ln_b, w_ple_gate, w_ple_proj):
    for i in range(DEPTH):
        j = i // N_MIXERS
        if i % N_MIXERS == 0:
            y = sgu_mixer(x, w_in_a[j], sgu_norm_g[j], sgu_norm_b[j], w_s[j], b_s[j])
        else:
            y = moba_mixer(x, w_in_b[j])
        y = y @ w_out[i]
        x = layer_norm(DEEPNORM_ALPHA * x + y, ln_g[i], ln_b[i])
        x = x + jax.nn.sigmoid(x @ w_ple_gate[i]) * (p[i] @ w_ple_proj[i])
    return x
```

```cpp
#include <hip/hip_runtime.h>
#include <hip/hip_cooperative_groups.h>
#include <cstdio>
namespace cg = cooperative_groups;

#ifndef ONE_LAUNCH
#define ONE_LAUNCH 1
#endif

#define LAS __attribute__((address_space(3)))
typedef unsigned short bf16_t;
typedef short bf16x8 __attribute__((ext_vector_type(8)));
typedef float f32x4 __attribute__((ext_vector_type(4)));
typedef float f32x2 __attribute__((ext_vector_type(2)));
typedef float f32x16 __attribute__((ext_vector_type(16)));
typedef unsigned u32x4 __attribute__((ext_vector_type(4)));
typedef unsigned u32x2 __attribute__((ext_vector_type(2)));

constexpr int MTOK = 8192, DM = 2048, SEQ = 2048;
constexpr int NTHREADS = 512;
constexpr int LDS_MAIN = 131072, LDS_BYTES = LDS_MAIN + 16;
constexpr size_t TT = 33554432ull;
constexpr size_t WS_WINB = 0, WS_WOUT1 = TT, WS_WG1 = TT + TT / 4, WS_WP = TT + TT / 2, WS_PB = WS_WP + TT / 16, WS_MISC = WS_PB + TT / 4;
constexpr size_t WS_STATS = WS_MISC, WS_KPART = WS_MISC + (2u << 20), WS_WSB = WS_KPART + (512u << 10), WS_BAR = WS_WSB + (512u << 10), WS_CNT = WS_BAR + 16384, WS_SLOTS = WS_CNT + 32768;
constexpr size_t WS_SLOTA = 2 * TT, WS_WINA = 3 * TT, WS_WOUT0 = 3 * TT + 3 * (TT / 4), WS_WG0 = 4 * TT, WS_U = 4 * TT + TT / 4, WS_GV = WS_U + TT, WS_SZ = WS_GV + TT;
constexpr size_t WS_Q = 3 * TT, WS_K = 4 * TT, WS_VT = 5 * TT, WS_Z = 6 * TT, WS_PP1 = 7 * TT, WS_X3B = 4 * TT, WS_PP0 = WS_U, WS_X1B = WS_GV;
constexpr size_t WS_END = 8 * TT;
static_assert(WS_SZ + TT <= WS_END && WS_WSB + (512u << 10) <= WS_SLOTA && WS_GV == WS_U + TT && WS_SZ == WS_U + 2 * TT && WS_K == WS_Q + TT && WS_VT == WS_Q + 2 * TT && WS_Z == WS_Q + 3 * TT, "workspace map");

struct Params {
    const float* x; const float* p; const float* w_in_a; const float* sgu_g; const float* sgu_b; const float* w_s; const float* b_s; const float* w_in_b;
    const float* w_out; const float* ln_g; const float* ln_b; const float* w_gate; const float* w_proj;
    float* out; unsigned char* ws; int lo, hi;
};

__device__ __forceinline__ unsigned cvt_pk_bf16(float lo, float hi) { unsigned r; asm volatile("v_cvt_pk_bf16_f32 %0, %1, %2" : "=v"(r) : "v"(lo), "v"(hi)); return r; }
__device__ __forceinline__ unsigned cvt_pk_bf16_t(float lo, float hi) { unsigned r; asm volatile("s_nop 1\n\tv_cvt_pk_bf16_f32 %0, %1, %2" : "=v"(r) : "v"(lo), "v"(hi)); return r; }
__device__ __forceinline__ float bf_lo(unsigned w) { return __uint_as_float(w << 16); }
__device__ __forceinline__ float bf_hi(unsigned w) { return __uint_as_float(w & 0xffff0000u); }
__device__ __forceinline__ float fast_sigmoid(float v) { return __builtin_amdgcn_rcpf(1.0f + __builtin_amdgcn_exp2f(-1.4426950408889634f * v)); }
__device__ __forceinline__ float silu_f(float v) { return v * fast_sigmoid(v); }
__device__ __forceinline__ float gelu_f(float v) { const float u = 1.5957691216057308f * (v + 0.044715f * v * v * v); return v * fast_sigmoid(u); }

namespace pg8 {
constexpr int BM = 256, BK = 64, HALF = 128, HTB = HALF * BK * 2, STAGE_BYTES = 8 * HTB, NXCD = 8, WGM = 8;
__host__ __device__ __forceinline__ int lds_byte(int r, int c) { const int st = (r >> 4) * 2 + (c >> 5), rr = r & 15, cc = c & 31, ob = rr * 64 + cc * 2; return st * 1024 + (ob ^ (((ob >> 9) & 1) << 5)); }
__host__ __device__ __forceinline__ void stage_rc(int b, int& R, int& C) { const int st = b / 1024, sb = b % 1024, swz = sb ^ (((sb >> 9) & 1) << 5); R = (st >> 1) * 16 + swz / 64; C = (st & 1) * 32 + (swz % 64) / 2; }
__host__ __device__ __forceinline__ int perm32(int rho) { const int n = rho >> 4, i = rho & 15; return 8 * (i >> 2) + 4 * n + (i & 3); }
struct Unit { int pm, pn; };
struct Gemm { const bf16_t* A; const bf16_t* Bt; int M, N, K; int bsplit, badd; };
struct StaticOrder {
    int nM, nN, nwg, G, c;
    __device__ void init(int M, int N, int G_, int c_) { nM = M / BM; nN = N / BM; nwg = nM * nN; G = G_; c = c_; }
    __device__ bool next(int i, Unit& u) const {
        const long L = (long)i * G + c; if (L >= nwg) return false;
        int wgid = (int)L; { const int q = nwg / NXCD, r = nwg % NXCD, xcd = wgid % NXCD, off = wgid / NXCD; wgid = (xcd < r ? xcd * (q + 1) : r * (q + 1) + (xcd - r) * q) + off; }
        const int nig = WGM * nN, gid = wgid / nig, fm = gid * WGM, gsz = (nM - fm) < WGM ? (nM - fm) : WGM;
        u.pm = fm + ((wgid % nig) % gsz); u.pn = (wgid % nig) / gsz; return true;
    }
};
template <class Epi, bool ALIGN_EPI = false, bool SP2 = true>
__device__ __forceinline__ void gemm_phase(LAS unsigned char* lds, const Gemm g, const StaticOrder& S, const Epi& E) {
    const int tid = threadIdx.x, wid = __builtin_amdgcn_readfirstlane(tid >> 6), lane = tid & 63, wr = wid >> 2, wc = wid & 3, fr = lane & 15, fq = lane >> 4;
    const int K = g.K, nt = K / BK;
    unsigned voffA[2], voffB[2];
#pragma unroll
    for (int i = 0; i < 2; ++i) { int R, C; stage_rc(tid * 16 + i * 8192, R, C); const int Rb = (R & ~31) + perm32(R & 31);
        voffA[i] = (unsigned)(R * K + C) * 2u; voffB[i] = (unsigned)(Rb * K + C) * 2u; }
    const size_t kstep = (size_t)(BK * 2);
    const size_t hstep = (size_t)HALF * K * 2;
    const size_t tstep = 2 * hstep;
    const unsigned ldsw = (unsigned)wid * 1024u;
    const int aoff = lds_byte(wr * 64 + fr, fq * 8), boff = lds_byte(wc * 32 + fr, fq * 8);
#define PG8_SA(b, h) (((b) * 2 + (h)) * HTB)
#define PG8_SB(b, h) ((4 + (b) * 2 + (h)) * HTB)
#define PG8_STAGE(bufoff, gbase, voff) do { _Pragma("unroll") for (int _i = 0; _i < 2; ++_i) \
        __builtin_amdgcn_global_load_lds((const unsigned*)((const char*)(gbase) + (voff)[_i]), (LAS unsigned*)(lds + (bufoff) + ldsw + _i * 8192), 16, 0, 0); } while (0)
#define PG8_LDA(dst, b, h) do { _Pragma("unroll") for (int m = 0; m < 4; ++m) _Pragma("unroll") for (int k = 0; k < 2; ++k) dst[m][k] = *(const LAS bf16x8*)(lds + PG8_SA(b, h) + aoff + m * 2048 + k * 1024); } while (0)
#define PG8_LDB(dst, b, h) do { _Pragma("unroll") for (int n = 0; n < 2; ++n) _Pragma("unroll") for (int k = 0; k < 2; ++k) dst[n][k] = *(const LAS bf16x8*)(lds + PG8_SB(b, h) + boff + n * 2048 + k * 1024); } while (0)
#define PG8_MMA(ai, bj, At, Bt) do { __builtin_amdgcn_s_setprio(1); _Pragma("unroll") for (int m = 0; m < 4; ++m) _Pragma("unroll") for (int n = 0; n < 2; ++n) _Pragma("unroll") for (int k = 0; k < 2; ++k) \
        acc[ai][bj][m][n] = __builtin_amdgcn_mfma_f32_16x16x32_bf16(Bt[n][k], At[m][k], acc[ai][bj][m][n], 0, 0, 0); __builtin_amdgcn_s_setprio(0); } while (0)
#define PG8_WAIT_V(n) asm volatile("s_waitcnt vmcnt(" #n ")" ::: "memory")
#define PG8_WAIT_L(n) asm volatile("s_waitcnt lgkmcnt(" #n ")" ::: "memory")
#define PG8_BAR __builtin_amdgcn_s_barrier()
#define PG8_SCHED __builtin_amdgcn_sched_barrier(0)
    Unit cur, nxt; int ui = 0;
    if (!S.next(0, cur)) return;
    f32x4 acc[2][2][4][2];
#pragma unroll
    for (int a = 0; a < 2; ++a)
#pragma unroll
        for (int b = 0; b < 2; ++b)
#pragma unroll
            for (int m = 0; m < 4; ++m)
#pragma unroll
                for (int n = 0; n < 2; ++n) acc[a][b][m][n] = (f32x4){0.f, 0.f, 0.f, 0.f};
    bf16x8 At[4][2], B0[2][2], B1[2][2];
    const char* cA = (const char*)g.A + (size_t)cur.pm * tstep; const char* cB = (const char*)g.Bt + (size_t)(cur.pn + (cur.pm >= g.bsplit ? g.badd : 0)) * tstep;
    if constexpr (SP2) {
        PG8_STAGE(PG8_SB(0, 0), cB, voffB); PG8_STAGE(PG8_SB(0, 1), cB + hstep, voffB); PG8_STAGE(PG8_SA(0, 0), cA, voffA); PG8_STAGE(PG8_SA(0, 1), cA + hstep, voffA);
        if (wr == 1) PG8_BAR;
        PG8_WAIT_V(2); PG8_BAR;
        PG8_STAGE(PG8_SB(1, 0), cB + kstep, voffB); PG8_STAGE(PG8_SA(1, 0), cA + kstep, voffA); PG8_STAGE(PG8_SB(1, 1), cB + hstep + kstep, voffB);
        PG8_WAIT_V(6); PG8_BAR;
    } else {
        PG8_STAGE(PG8_SB(0, 0), cB, voffB); PG8_STAGE(PG8_SA(0, 0), cA, voffA); PG8_STAGE(PG8_SB(0, 1), cB + hstep, voffB); PG8_STAGE(PG8_SA(0, 1), cA + hstep, voffA);
        if (wr == 1) PG8_BAR;
        PG8_WAIT_V(4); PG8_BAR;
        PG8_STAGE(PG8_SB(1, 0), cB + kstep, voffB); PG8_STAGE(PG8_SA(1, 0), cA + kstep, voffA); PG8_STAGE(PG8_SB(1, 1), cB + hstep + kstep, voffB);
        PG8_WAIT_V(6); PG8_BAR;
    }
    for (;;) {
        const bool has_next = S.next(ui + 1, nxt);
        const char* nA = has_next ? (const char*)g.A + (size_t)nxt.pm * tstep : cA; const char* nB = has_next ? (const char*)g.Bt + (size_t)(nxt.pn + (nxt.pm >= g.bsplit ? g.badd : 0)) * tstep : cB;
        for (int t = 0; t < nt; t += 2) {
            const bool last = (t == nt - 2);
            const char* a1 = cA + (size_t)(t + 1) * kstep;
            const char* a2 = last ? nA : cA + (size_t)(t + 2) * kstep; const char* b2 = last ? nB : cB + (size_t)(t + 2) * kstep;
            const char* a3 = a2 + kstep; const char* b3 = b2 + kstep;
            if constexpr (SP2) {
            PG8_LDB(B0, 0, 0); PG8_LDB(B1, 0, 1); PG8_SCHED; PG8_LDA(At, 0, 0); PG8_STAGE(PG8_SA(1, 1), a1 + hstep, voffA);
            PG8_WAIT_V(8); PG8_WAIT_L(0); PG8_BAR; PG8_MMA(0, 0, At, B0); PG8_MMA(0, 1, At, B1); PG8_BAR; PG8_SCHED;
            PG8_LDA(At, 0, 1); PG8_STAGE(PG8_SB(0, 0), b2, voffB); PG8_STAGE(PG8_SB(0, 1), b2 + hstep, voffB); PG8_STAGE(PG8_SA(0, 0), a2, voffA);
            PG8_WAIT_V(8); PG8_WAIT_L(0); PG8_BAR; PG8_MMA(1, 0, At, B0); PG8_MMA(1, 1, At, B1); PG8_BAR; PG8_SCHED;
            PG8_LDB(B0, 1, 0); PG8_LDB(B1, 1, 1); PG8_SCHED; PG8_LDA(At, 1, 0); PG8_STAGE(PG8_SA(0, 1), a2 + hstep, voffA);
            PG8_WAIT_V(8); PG8_WAIT_L(0); PG8_BAR; PG8_MMA(0, 0, At, B0); PG8_MMA(0, 1, At, B1); PG8_BAR; PG8_SCHED;
            PG8_LDA(At, 1, 1); PG8_STAGE(PG8_SB(1, 0), b3, voffB); PG8_STAGE(PG8_SB(1, 1), b3 + hstep, voffB); PG8_STAGE(PG8_SA(1, 0), a3, voffA);
            PG8_WAIT_V(8); PG8_WAIT_L(0); PG8_BAR; PG8_MMA(1, 0, At, B0); PG8_MMA(1, 1, At, B1); PG8_BAR; PG8_SCHED;
            } else {
            PG8_LDB(B0, 0, 0); PG8_SCHED; PG8_LDA(At, 0, 0); PG8_STAGE(PG8_SA(1, 1), a1 + hstep, voffA);
            PG8_WAIT_L(8); PG8_BAR; PG8_WAIT_L(0); PG8_MMA(0, 0, At, B0); PG8_BAR; PG8_SCHED;
            PG8_LDB(B1, 0, 1); PG8_STAGE(PG8_SB(0, 0), b2, voffB);
            PG8_BAR; PG8_WAIT_L(0); PG8_MMA(0, 1, At, B1); PG8_BAR;
            PG8_LDA(At, 0, 1); PG8_STAGE(PG8_SA(0, 0), a2, voffA);
            PG8_BAR; PG8_WAIT_L(0); PG8_MMA(1, 0, At, B0); PG8_BAR; PG8_SCHED;
            PG8_STAGE(PG8_SB(0, 1), b2 + hstep, voffB);
            PG8_WAIT_V(6); PG8_BAR; PG8_MMA(1, 1, At, B1); PG8_BAR;
            PG8_LDB(B0, 1, 0); PG8_SCHED; PG8_LDA(At, 1, 0); PG8_STAGE(PG8_SA(0, 1), a2 + hstep, voffA);
            PG8_WAIT_L(8); PG8_BAR; PG8_WAIT_L(0); PG8_MMA(0, 0, At, B0); PG8_BAR; PG8_SCHED;
            PG8_LDB(B1, 1, 1); PG8_STAGE(PG8_SB(1, 0), b3, voffB);
            PG8_BAR; PG8_WAIT_L(0); PG8_MMA(0, 1, At, B1); PG8_BAR;
            PG8_LDA(At, 1, 1); PG8_STAGE(PG8_SA(1, 0), a3, voffA);
            PG8_BAR; PG8_WAIT_L(0); PG8_MMA(1, 0, At, B0); PG8_BAR; PG8_SCHED;
            PG8_STAGE(PG8_SB(1, 1), b3 + hstep, voffB);
            PG8_WAIT_V(6); PG8_BAR; PG8_MMA(1, 1, At, B1); PG8_BAR;
            }
        }
        if constexpr (ALIGN_EPI) { if (wr == 0) PG8_BAR; }
        if constexpr (!Epi::AFTER_DRAIN) E(acc, cur, wr, wc, fr, fq);
        if (!has_next) break;
#pragma unroll
        for (int a = 0; a < 2; ++a)
#pragma unroll
            for (int b = 0; b < 2; ++b)
#pragma unroll
                for (int m = 0; m < 4; ++m)
#pragma unroll
                    for (int n = 0; n < 2; ++n) acc[a][b][m][n] = (f32x4){0.f, 0.f, 0.f, 0.f};
        cur = nxt; cA = nA; cB = nB; ++ui;
        if constexpr (ALIGN_EPI) { if (wr == 1) PG8_BAR; }
    }
    PG8_WAIT_V(0);
    if constexpr (!ALIGN_EPI) { if (wr == 0) PG8_BAR; }
    PG8_BAR;
    if constexpr (Epi::AFTER_DRAIN) E.fused(acc, cur, wr, wc, fr, fq, lds, wid, lane);
#undef PG8_SA
#undef PG8_SB
#undef PG8_STAGE
#undef PG8_LDA
#undef PG8_LDB
#undef PG8_MMA
#undef PG8_WAIT_V
#undef PG8_WAIT_L
#undef PG8_BAR
#undef PG8_SCHED
}
}
using pg8::Unit;
typedef f32x4 Acc[2][2][4][2];

__device__ __forceinline__ u32x4 pack8(const f32x4 a, const f32x4 b) { u32x4 w; w.x = cvt_pk_bf16(a[0], a[1]); w.y = cvt_pk_bf16(a[2], a[3]); w.z = cvt_pk_bf16(b[0], b[1]); w.w = cvt_pk_bf16(b[2], b[3]); return w; }

struct EpiL0In {
    static constexpr bool AFTER_DRAIN = false;
    bf16_t* UZ; bf16_t* GV; float* stats;
    __device__ __forceinline__ void operator()(const Acc& acc, const Unit& u, int wr, int wc, int fr, int fq) const {
        if (u.pn < 16) {
            const int cb = u.pn * 128 + wc * 32 + 8 * fq;
#pragma unroll
            for (int ai = 0; ai < 2; ++ai)
#pragma unroll
                for (int m = 0; m < 4; ++m) {
                    const int row = u.pm * 256 + ai * 128 + wr * 64 + m * 16 + fr;
                    f32x4 a0 = acc[ai][0][m][0], a1 = acc[ai][0][m][1]; const f32x4 z0 = acc[ai][1][m][0], z1 = acc[ai][1][m][1];
#pragma unroll
                    for (int j = 0; j < 4; ++j) { a0[j] = gelu_f(a0[j]) * silu_f(z0[j]); a1[j] = gelu_f(a1[j]) * silu_f(z1[j]); }
                    *(u32x4*)(UZ + (size_t)row * DM + cb) = pack8(a0, a1);
                }
        } else {
            const int pnv = u.pn - 16, cb = pnv * 256 + wc * 32 + 8 * fq;
#pragma unroll
            for (int ai = 0; ai < 2; ++ai)
#pragma unroll
                for (int m = 0; m < 4; ++m) {
                    const int row = u.pm * 256 + ai * 128 + wr * 64 + m * 16 + fr;
                    float s = 0.f, ss = 0.f;
#pragma unroll
                    for (int bj = 0; bj < 2; ++bj) {
                        f32x4 v0 = acc[ai][bj][m][0], v1 = acc[ai][bj][m][1];
#pragma unroll
                        for (int j = 0; j < 4; ++j) { v0[j] = gelu_f(v0[j]); v1[j] = gelu_f(v1[j]); }
#pragma unroll
                        for (int j = 0; j < 4; ++j) { s += v0[j] + v1[j]; ss += v0[j] * v0[j] + v1[j] * v1[j]; }
                        *(u32x4*)(GV + (size_t)row * DM + cb + bj * 128) = pack8(v0, v1);
                    }
                    s += __shfl_xor(s, 16); s += __shfl_xor(s, 32); ss += __shfl_xor(ss, 16); ss += __shfl_xor(ss, 32);
                    if (fq == 0) *(f32x2*)(stats + ((size_t)row * 32 + pnv * 4 + wc) * 2) = (f32x2){s, ss};
                }
        }
    }
};
struct EpiPlain {
    static constexpr bool AFTER_DRAIN = false;
    bf16_t* O; long long delta2;
    __device__ __forceinline__ void operator()(const Acc& acc, const Unit& u, int wr, int wc, int fr, int fq) const {
        const int cb = u.pn * 256 + wc * 32 + 8 * fq;
        bf16_t* Ob = O + (u.pm >= 32 ? delta2 - (long long)32 * 256 * DM : 0ll);
#pragma unroll
        for (int ai = 0; ai < 2; ++ai)
#pragma unroll
            for (int m = 0; m < 4; ++m) {
                const int row = u.pm * 256 + ai * 128 + wr * 64 + m * 16 + fr;
#pragma unroll
                for (int bj = 0; bj < 2; ++bj) *(u32x4*)(Ob + (size_t)row * DM + cb + bj * 128) = pack8(acc[ai][bj][m][0], acc[ai][bj][m][1]);
            }
    }
};
struct EpiRes {
    static constexpr bool AFTER_DRAIN = false;
    const float* res; float* out; float* stats; float alpha;
    __device__ __forceinline__ void operator()(const Acc& acc, const Unit& u, int wr, int wc, int fr, int fq) const {
        const int cb = u.pn * 256 + wc * 32 + 8 * fq;
#pragma unroll
        for (int ai = 0; ai < 2; ++ai)
#pragma unroll
            for (int m = 0; m < 4; ++m) {
                const int row = u.pm * 256 + ai * 128 + wr * 64 + m * 16 + fr;
                float s = 0.f, ss = 0.f;
#pragma unroll
                for (int bj = 0; bj < 2; ++bj) {
                    const size_t o = (size_t)row * DM + cb + bj * 128;
                    const f32x4 r0 = *(const f32x4*)(res + o), r1 = *(const f32x4*)(res + o + 4);
                    const f32x4 t0 = r0 * alpha + acc[ai][bj][m][0], t1 = r1 * alpha + acc[ai][bj][m][1];
#pragma unroll
                    for (int j = 0; j < 4; ++j) { s += t0[j] + t1[j]; ss += t0[j] * t0[j] + t1[j] * t1[j]; }
                    *(f32x4*)(out + o) = t0; *(f32x4*)(out + o + 4) = t1;
                }
                s += __shfl_xor(s, 16); s += __shfl_xor(s, 32); ss += __shfl_xor(ss, 16); ss += __shfl_xor(ss, 32);
                if (fq == 0) *(f32x2*)(stats + ((size_t)row * 32 + u.pn * 4 + wc) * 2) = (f32x2){s, ss};
            }
    }
};
template <bool RES_BF16> struct EpiResLn {
    static constexpr bool AFTER_DRAIN = true;
    const void* res; bf16_t* xb; const float* g; const float* b; unsigned char* ws; int layer, pad;
    static constexpr float alpha = 1.4142135623730951f;
    __device__ __forceinline__ void operator()(const Acc&, const Unit&, int, int, int, int) const {}
    __device__ __forceinline__ void fused(Acc& acc, const Unit& u, int wr, int wc, int fr, int fq, LAS unsigned char* lds, int wid, int lane) const {
        const int cb = u.pn * 256 + wc * 32 + 8 * fq;
        LAS f32x2* Pt = (LAS f32x2*)lds;
        LAS f32x2* St = (LAS f32x2*)(lds + 8192);
        unsigned long long* slots = (unsigned long long*)(ws + WS_SLOTS) + (size_t)layer * MTOK * 8; unsigned* cnt = (unsigned*)(ws + WS_CNT) + layer * 64 * 32;
#pragma unroll
        for (int ai = 0; ai < 2; ++ai) {
            const size_t ob = (size_t)(u.pm * 256 + ai * 128 + wr * 64 + fr) * DM + cb;
            f32x4 rr[4][2][2];
#pragma unroll
            for (int m = 0; m < 4; ++m)
#pragma unroll
                for (int bj = 0; bj < 2; ++bj) {
                    const size_t o = ob + (size_t)m * 16 * DM + bj * 128;
                    if constexpr (RES_BF16) { const u32x4 rw = *(const u32x4*)((const bf16_t*)res + o);
                        rr[m][bj][0] = (f32x4){bf_lo(rw.x), bf_hi(rw.x), bf_lo(rw.y), bf_hi(rw.y)}; rr[m][bj][1] = (f32x4){bf_lo(rw.z), bf_hi(rw.z), bf_lo(rw.w), bf_hi(rw.w)}; }
                    else { rr[m][bj][0] = *(const f32x4*)((const float*)res + o); rr[m][bj][1] = *(const f32x4*)((const float*)res + o + 4); }
                }
#pragma unroll
            for (int m = 0; m < 4; ++m) {
                const int rl = ai * 128 + wr * 64 + m * 16 + fr;
                float s = 0.f, ss = 0.f;
#pragma unroll
                for (int bj = 0; bj < 2; ++bj) {
                    const f32x4 t0 = rr[m][bj][0] * alpha + acc[ai][bj][m][0], t1 = rr[m][bj][1] * alpha + acc[ai][bj][m][1];
                    acc[ai][bj][m][0] = t0; acc[ai][bj][m][1] = t1;
#pragma unroll
                    for (int j = 0; j < 4; ++j) { s += t0[j] + t1[j]; ss += t0[j] * t0[j] + t1[j] * t1[j]; }
                }
                s += __shfl_xor(s, 16); s += __shfl_xor(s, 32); ss += __shfl_xor(ss, 16); ss += __shfl_xor(ss, 32);
                if (fq == 0) Pt[rl * 4 + wc] = (f32x2){s, ss};
            }
        }
        asm volatile("s_waitcnt lgkmcnt(0)" ::: "memory"); __builtin_amdgcn_s_barrier(); asm volatile("" ::: "memory");
        const int rowi = wid * 32 + (lane & 31);
        if (lane < 32) {
            const f32x2 a = Pt[rowi * 4 + 0], b2 = Pt[rowi * 4 + 1], c = Pt[rowi * 4 + 2], d = Pt[rowi * 4 + 3];
            const float S = (a.x + b2.x) + (c.x + d.x), SS = (a.y + b2.y) + (c.y + d.y);
            unsigned long long* slot = slots + ((size_t)(u.pm * 256 + rowi) * 8 + u.pn);
            __hip_atomic_store(slot, ((unsigned long long)__float_as_uint(SS) << 32) | __float_as_uint(S), __ATOMIC_RELAXED, __HIP_MEMORY_SCOPE_AGENT);
        }
        asm volatile("s_waitcnt vmcnt(0)" ::: "memory");
        if (lane == 0) __hip_atomic_fetch_add(cnt + 64 * u.pm, 1u, __ATOMIC_RELAXED, __HIP_MEMORY_SCOPE_AGENT);
        if (wid == 0) {
            unsigned sp = 0u;
            while ((unsigned)__builtin_amdgcn_readfirstlane(__hip_atomic_load(cnt + 64 * u.pm, __ATOMIC_RELAXED, __HIP_MEMORY_SCOPE_AGENT)) < 64u) { __builtin_amdgcn_s_sleep(2); if (++sp > (1u << 22)) break; }
            __builtin_amdgcn_fence(__ATOMIC_ACQUIRE, "agent");
        }
        asm volatile("s_waitcnt vmcnt(0) lgkmcnt(0)" ::: "memory"); __builtin_amdgcn_s_barrier(); asm volatile("" ::: "memory");
        if (lane < 32) {
            const unsigned long long* slot = slots + (size_t)(u.pm * 256 + rowi) * 8; float S = 0.f, SS = 0.f;
#pragma unroll
            for (int t = 0; t < 8; ++t) { const unsigned long long w = __hip_atomic_load(slot + t, __ATOMIC_RELAXED, __HIP_MEMORY_SCOPE_AGENT); S += __uint_as_float((unsigned)w); SS += __uint_as_float((unsigned)(w >> 32)); }
            const float mean = S * (1.0f / DM), var = SS * (1.0f / DM) - mean * mean;
            St[rowi] = (f32x2){mean, rsqrtf(var + 1e-5f)};
        }
        asm volatile("s_waitcnt lgkmcnt(0)" ::: "memory"); __builtin_amdgcn_s_barrier(); asm volatile("" ::: "memory");
#pragma unroll
        for (int bj = 0; bj < 2; ++bj) {
            const f32x4 g0 = *(const f32x4*)(g + cb + bj * 128), g1 = *(const f32x4*)(g + cb + bj * 128 + 4), b0 = *(const f32x4*)(b + cb + bj * 128), b1 = *(const f32x4*)(b + cb + bj * 128 + 4);
#pragma unroll
            for (int ai = 0; ai < 2; ++ai)
#pragma unroll
                for (int m = 0; m < 4; ++m) {
                    const int rl = ai * 128 + wr * 64 + m * 16 + fr;
                    const f32x2 st = St[rl];
                    const size_t o = (size_t)(u.pm * 256 + rl) * DM + cb + bj * 128;
                    const f32x4 o0 = (acc[ai][bj][m][0] - st.x) * st.y * g0 + b0, o1 = (acc[ai][bj][m][1] - st.x) * st.y * g1 + b1;
                    *(u32x4*)(xb + o) = pack8(o0, o1);
                }
        }
    }
};
template <bool OUT_F32> struct EpiPle {
    static constexpr bool AFTER_DRAIN = false;
    const bf16_t* xin; const bf16_t* pp; bf16_t* xb; float* outf;
    __device__ __forceinline__ void operator()(const Acc& acc, const Unit& u, int wr, int wc, int fr, int fq) const {
        const int cb = u.pn * 256 + wc * 32 + 8 * fq;
#pragma unroll
        for (int ai = 0; ai < 2; ++ai) {
            const size_t o0 = (size_t)(u.pm * 256 + ai * 128 + wr * 64 + fr) * DM + cb;
            u32x4 xw[4][2], pw[4][2];
#pragma unroll
            for (int m = 0; m < 4; ++m)
#pragma unroll
                for (int bj = 0; bj < 2; ++bj) { const size_t o = o0 + (size_t)m * 16 * DM + bj * 128; xw[m][bj] = *(const u32x4*)(xin + o); pw[m][bj] = *(const u32x4*)(pp + o); }
#pragma unroll
            for (int m = 0; m < 4; ++m)
#pragma unroll
                for (int bj = 0; bj < 2; ++bj) {
                    const size_t o = o0 + (size_t)m * 16 * DM + bj * 128;
                    const u32x4 x = xw[m][bj], p = pw[m][bj];
                    const f32x4 a0 = acc[ai][bj][m][0], a1 = acc[ai][bj][m][1];
                    f32x4 r0, r1;
                    r0[0] = bf_lo(x.x) + fast_sigmoid(a0[0]) * bf_lo(p.x); r0[1] = bf_hi(x.x) + fast_sigmoid(a0[1]) * bf_hi(p.x);
                    r0[2] = bf_lo(x.y) + fast_sigmoid(a0[2]) * bf_lo(p.y); r0[3] = bf_hi(x.y) + fast_sigmoid(a0[3]) * bf_hi(p.y);
                    r1[0] = bf_lo(x.z) + fast_sigmoid(a1[0]) * bf_lo(p.z); r1[1] = bf_hi(x.z) + fast_sigmoid(a1[1]) * bf_hi(p.z);
                    r1[2] = bf_lo(x.w) + fast_sigmoid(a1[2]) * bf_lo(p.w); r1[3] = bf_hi(x.w) + fast_sigmoid(a1[3]) * bf_hi(p.w);
                    if constexpr (OUT_F32) { *(f32x4*)(outf + o) = r0; *(f32x4*)(outf + o + 4) = r1; }
                    else *(u32x4*)(xb + o) = pack8(r0, r1);
                }
        }
    }
};
struct EpiL1In {
    static constexpr bool AFTER_DRAIN = false;
    bf16_t* Q; bf16_t* Kb; bf16_t* VT; bf16_t* Z; float* kpart;
    __device__ __forceinline__ void operator()(const Acc& acc, const Unit& u, int wr, int wc, int fr, int fq) const {
        const int type = u.pn >> 3, cb = (u.pn & 7) * 256 + wc * 32 + 8 * fq;
        if (type == 2) {
            const int b = u.pm >> 3, sb = (u.pm & 7) * 256 + wr * 64;
            const int pos = (fr < 4 || fr >= 12) ? fr : (fr < 8 ? fr + 4 : fr - 4);
#pragma unroll
            for (int bj = 0; bj < 2; ++bj)
#pragma unroll
                for (int n = 0; n < 2; ++n)
#pragma unroll
                    for (int j = 0; j < 4; ++j) {
                        const int c = cb + bj * 128 + 4 * n + j, h = c >> 7, d = c & 127;
                        bf16_t* base = VT + ((size_t)((b * 16 + h) * 128 + d)) * SEQ + sb + pos;
#pragma unroll
                        for (int ai = 0; ai < 2; ++ai)
#pragma unroll
                            for (int m = 0; m < 4; ++m) base[ai * 128 + m * 16] = (bf16_t)(cvt_pk_bf16(acc[ai][bj][m][n][j], 0.f) & 0xffffu);
                    }
            return;
        }
        bf16_t* O = Q + (size_t)type * (TT / 2);
        const float qs = 0.08838834764831845f * 1.4426950408889634f;
#pragma unroll
        for (int ai = 0; ai < 2; ++ai)
#pragma unroll
            for (int m = 0; m < 4; ++m) {
                const int row = u.pm * 256 + ai * 128 + wr * 64 + m * 16 + fr;
#pragma unroll
                for (int bj = 0; bj < 2; ++bj) {
                    f32x4 v0 = acc[ai][bj][m][0], v1 = acc[ai][bj][m][1];
                    if (type == 0) { v0 *= qs; v1 *= qs; }
                    if (type == 3) {
#pragma unroll
                        for (int j = 0; j < 4; ++j) { v0[j] = silu_f(v0[j]); v1[j] = silu_f(v1[j]); }
                    }
                    *(u32x4*)(O + (size_t)row * DM + cb + bj * 128) = pack8(v0, v1);
                }
            }
        if (type == 1) {
            float* kp = kpart + ((size_t)(u.pm * 2 + wr)) * DM;
#pragma unroll
            for (int bj = 0; bj < 2; ++bj)
#pragma unroll
                for (int n = 0; n < 2; ++n) {
                    f32x4 cs = (f32x4){0.f, 0.f, 0.f, 0.f};
#pragma unroll
                    for (int ai = 0; ai < 2; ++ai)
#pragma unroll
                        for (int m = 0; m < 4; ++m) cs += acc[ai][bj][m][n];
#pragma unroll
                    for (int j = 0; j < 4; ++j) { float v = cs[j]; v += __shfl_xor(v, 1); v += __shfl_xor(v, 2); v += __shfl_xor(v, 4); v += __shfl_xor(v, 8); cs[j] = v; }
                    if (fr == 0) *(f32x4*)(kp + cb + bj * 128 + 4 * n) = cs;
                }
        }
    }
};

template <bool REMAP = false>
__device__ __forceinline__ void transpose_convert(LAS unsigned char* lds, const float* src, bf16_t* dst, int K, int N, int G, int bid) {
    LAS float* tile = (LAS float*)lds;
    const int tid = threadIdx.x, ntn = N / 64, ntiles = (K / 128) * ntn;
    const int r0 = tid >> 4, c4 = tid & 15;
    f32x4 v[4];
    if (bid < ntiles) { const int k0 = (bid / ntn) * 128, n0 = (bid % ntn) * 64;
#pragma unroll
        for (int i = 0; i < 4; ++i) v[i] = __builtin_nontemporal_load((const f32x4*)(src + (size_t)(k0 + r0 + 32 * i) * N + n0 + c4 * 4)); }
    for (int t = bid; t < ntiles; t += G) {
        const int k0 = (t / ntn) * 128, n0 = (t % ntn) * 64;
        asm volatile("s_waitcnt lgkmcnt(0)" ::: "memory"); __builtin_amdgcn_s_barrier(); asm volatile("" ::: "memory");
#pragma unroll
        for (int i = 0; i < 4; ++i) {
#pragma unroll
            for (int j = 0; j < 4; ++j) tile[(r0 + 32 * i) * 65 + c4 * 4 + j] = v[i][j]; }
        asm volatile("s_waitcnt lgkmcnt(0)" ::: "memory"); __builtin_amdgcn_s_barrier(); asm volatile("" ::: "memory");
        if (t + G < ntiles) { const int k1 = ((t + G) / ntn) * 128, n1 = ((t + G) % ntn) * 64;
#pragma unroll
            for (int i = 0; i < 4; ++i) v[i] = __builtin_nontemporal_load((const f32x4*)(src + (size_t)(k1 + r0 + 32 * i) * N + n1 + c4 * 4)); }
#pragma unroll
        for (int i = 0; i < 2; ++i) { const int id = tid + 512 * i, n = id >> 4, kc = id & 15;
            float f[8];
#pragma unroll
            for (int j = 0; j < 8; ++j) f[j] = tile[(kc * 8 + j) * 65 + n];
            u32x4 w; w.x = cvt_pk_bf16(f[0], f[1]); w.y = cvt_pk_bf16(f[2], f[3]); w.z = cvt_pk_bf16(f[4], f[5]); w.w = cvt_pk_bf16(f[6], f[7]);
            const int nd = !REMAP ? n0 : (n0 < 2048 ? (n0 >> 7) * 256 + (n0 & 127) : (n0 < 4096 ? n0 + 2048 : ((n0 - 4096) >> 7) * 256 + 128 + (n0 & 127)));
            *(u32x4*)(dst + (size_t)(nd + n) * K + k0 + kc * 8) = w; }
    }
    __syncthreads();
}
__device__ __forceinline__ void convert_flat(const float* src, bf16_t* dst, size_t n, int G, int bid) {
    const size_t n8 = n / 8, stride = (size_t)G * NTHREADS;
    size_t i = (size_t)bid * NTHREADS + threadIdx.x;
    for (; i + 3 * stride < n8; i += 4 * stride) {
        f32x4 a[4], b[4];
#pragma unroll
        for (int u = 0; u < 4; ++u) { a[u] = __builtin_nontemporal_load((const f32x4*)(src + (i + u * stride) * 8)); b[u] = __builtin_nontemporal_load((const f32x4*)(src + (i + u * stride) * 8 + 4)); }
#pragma unroll
        for (int u = 0; u < 4; ++u) *(u32x4*)(dst + (i + u * stride) * 8) = pack8(a[u], b[u]);
    }
    for (; i < n8; i += stride) {
        const f32x4 a = __builtin_nontemporal_load((const f32x4*)(src + i * 8)), b = __builtin_nontemporal_load((const f32x4*)(src + i * 8 + 4));
        *(u32x4*)(dst + i * 8) = pack8(a, b);
    }
}

__device__ __forceinline__ void ln_apply_phase(float* xf, const float* stats, const float* g, const float* bta, bf16_t* xb, int G, int bid) {
    const int wid = threadIdx.x >> 6, lane = threadIdx.x & 63;
    for (int row = bid * 8 + wid; row < MTOK; row += G * 8) {
        float s = 0.f, ss = 0.f;
        if (lane < 32) { const f32x2 pr = *(const f32x2*)(stats + ((size_t)row * 32 + lane) * 2); s = pr.x; ss = pr.y; }
#pragma unroll
        for (int o = 32; o >= 1; o >>= 1) { s += __shfl_xor(s, o); ss += __shfl_xor(ss, o); }
        const float mean = s * (1.0f / DM), var = ss * (1.0f / DM) - mean * mean, rstd = rsqrtf(var + 1e-5f);
        float* xr = xf + (size_t)row * DM;
#pragma unroll
        for (int i = 0; i < 4; ++i) {
            const int c = i * 512 + lane * 8;
            const f32x4 t0 = *(const f32x4*)(xr + c), t1 = *(const f32x4*)(xr + c + 4);
            const f32x4 g0 = *(const f32x4*)(g + c), g1 = *(const f32x4*)(g + c + 4), b0 = *(const f32x4*)(bta + c), b1 = *(const f32x4*)(bta + c + 4);
            const f32x4 o0 = (t0 - mean) * rstd * g0 + b0, o1 = (t1 - mean) * rstd * g1 + b1;
            *(f32x4*)(xr + c) = o0; *(f32x4*)(xr + c + 4) = o1;
            *(u32x4*)(xb + (size_t)row * DM + c) = pack8(o0, o1);
        }
    }
}

__device__ __forceinline__ void sgu_phase(LAS unsigned char* lds, const bf16_t* U, const bf16_t* GV, const bf16_t* SZ, const float* stats, const float* vg, const float* vb,
                                          const bf16_t* wsb, const float* b_s, bf16_t* Y, int G, int bid) {
    constexpr int VST = 272;
    LAS unsigned char* vnT = lds;
    LAS f32x2* rstat = (LAS f32x2*)(lds + 128 * VST);
    const int tid = threadIdx.x, wid = tid >> 6, lane = tid & 63, fr = lane & 15, fq = lane >> 4;
    for (int it = bid; it < 1024; it += G) {
        const int ci = it >> 4, g = it & 15, row0 = ci * 128;
        __syncthreads();
        if (tid < 128) {
            const float* sp = stats + (size_t)(row0 + tid) * 64; float s = 0.f, ss = 0.f;
#pragma unroll
            for (int i = 0; i < 16; ++i) { const f32x4 q = *(const f32x4*)(sp + i * 4); s += q[0] + q[2]; ss += q[1] + q[3]; }
            const float mean = s * (1.0f / DM), var = ss * (1.0f / DM) - mean * mean;
            rstat[tid] = (f32x2){mean, rsqrtf(var + 1e-5f)};
        }
        __syncthreads();
#pragma unroll
        for (int i = 0; i < 4; ++i) {
            const int id = tid + 512 * i, r = id >> 4, cc = id & 15;
            const u32x4 w = *(const u32x4*)(GV + (size_t)(row0 + r) * DM + g * 128 + cc * 8);
            const f32x2 st = rstat[r];
            const f32x4 g0 = *(const f32x4*)(vg + g * 128 + cc * 8), g1 = *(const f32x4*)(vg + g * 128 + cc * 8 + 4);
            const f32x4 b0 = *(const f32x4*)(vb + g * 128 + cc * 8), b1 = *(const f32x4*)(vb + g * 128 + cc * 8 + 4);
            float f[8] = {bf_lo(w.x), bf_hi(w.x), bf_lo(w.y), bf_hi(w.y), bf_lo(w.z), bf_hi(w.z), bf_lo(w.w), bf_hi(w.w)};
#pragma unroll
            for (int j = 0; j < 8; ++j) {
                const float gg = j < 4 ? g0[j & 3] : g1[j & 3], bb = j < 4 ? b0[j & 3] : b1[j & 3];
                const float vn = (f[j] - st.x) * st.y * gg + bb;
                *(LAS bf16_t*)(vnT + (cc * 8 + j) * VST + (((r >> 3) ^ cc) << 4) + (r & 7) * 2) = (bf16_t)(cvt_pk_bf16(vn, 0.f) & 0xffffu);
            }
        }
        __syncthreads();
        f32x4 acc[8];
#pragma unroll
        for (int ct = 0; ct < 8; ++ct) acc[ct] = (f32x4){0.f, 0.f, 0.f, 0.f};
        const bf16_t* wrow = wsb + ((size_t)g * 128 + wid * 16 + fr) * 128 + fq * 8;
        const int nks = (wid >> 1) + 1;
        for (int ks = 0; ks < nks; ++ks) {
            const bf16x8 wf = *(const bf16x8*)(wrow + ks * 32);
#pragma unroll
            for (int ct = 0; ct < 8; ++ct) {
                const bf16x8 vf = *(const LAS bf16x8*)(vnT + (ct * 16 + fr) * VST + (((ks * 4 + fq) ^ (ct * 2 + (fr >> 3))) << 4));
                acc[ct] = __builtin_amdgcn_mfma_f32_16x16x32_bf16(vf, wf, acc[ct], 0, 0, 0);
            }
        }
        const int t = wid * 16 + fr; const float bs = b_s[g * 128 + t];
        const size_t ro = (size_t)(row0 + t) * DM + g * 128 + 4 * fq;
#pragma unroll
        for (int ct = 0; ct < 8; ++ct) {
            const u32x2 uw = *(const u32x2*)(U + ro + ct * 16);
            const float y0 = bf_lo(uw.x) * (acc[ct][0] + bs), y1 = bf_hi(uw.x) * (acc[ct][1] + bs);
            const float y2 = bf_lo(uw.y) * (acc[ct][2] + bs), y3 = bf_hi(uw.y) * (acc[ct][3] + bs);
            u32x2 o; o.x = cvt_pk_bf16(y0, y1); o.y = cvt_pk_bf16(y2, y3);
            *(u32x2*)(Y + ro + ct * 16) = o;
        }
    }
    __syncthreads();
}

#define MFMA32(a, b, c) __builtin_amdgcn_mfma_f32_32x32x16_bf16((a), (b), (c), 0, 0, 0)
__device__ __forceinline__ void attn_phase(LAS unsigned char* lds, const bf16_t* Q, const bf16_t* Kb, const bf16_t* VT, const bf16_t* Z, const float* kpart, bf16_t* Y, int G, int bid) {
    constexpr int KST = 272, VSTR = 144, KBUF = 64 * KST, VBUF = 128 * VSTR;
    const int tid = threadIdx.x, wid = __builtin_amdgcn_readfirstlane(tid >> 6), lane = tid & 63, qr = lane & 31, hh = lane >> 5;
    const float NEG = -__builtin_inff();
    for (int pair = bid; pair < 256; pair += G) {
        const int bh = pair >> 2, jp = pair & 3, b = bh >> 4, h = bh & 15;
        for (int half = 0; half < 2; ++half) {
            const int own = half == 0 ? 7 - jp : jp;
            const int q0 = own * 256 + wid * 32;
            const size_t qoff = (size_t)(b * SEQ + q0 + qr) * DM + h * 128;
            const int ntile = (own + 1) * 4;
            const bf16_t* kg = Kb + (size_t)(b * SEQ) * DM + h * 128;
            const bf16_t* vg = VT + (size_t)((b * 16 + h) * 128) * SEQ;
            u32x4 kreg[2], vreg[2];
#define ATT_LOAD(i_) do { const int _i = (i_); const int _kt = _i < 4 ? own * 4 + _i : _i - 4; \
                _Pragma("unroll") for (int c2 = 0; c2 < 2; ++c2) { const int id = tid + 512 * c2; \
                    kreg[c2] = *(const u32x4*)(kg + (size_t)(_kt * 64 + (id >> 4)) * DM + (id & 15) * 8); \
                    vreg[c2] = *(const u32x4*)(vg + (size_t)(id >> 3) * SEQ + _kt * 64 + (id & 7) * 8); } } while (0)
#define ATT_STORE(buf_) do { _Pragma("unroll") for (int c2 = 0; c2 < 2; ++c2) { const int id = tid + 512 * c2; \
                    *(LAS u32x4*)(lds + (buf_) * KBUF + (id >> 4) * KST + (id & 15) * 16) = kreg[c2]; \
                    *(LAS u32x4*)(lds + 2 * KBUF + (buf_) * VBUF + (id >> 3) * VSTR + (id & 7) * 16) = vreg[c2]; } } while (0)
            ATT_LOAD(0);
            bf16x8 Qf[8];
#pragma unroll
            for (int ks = 0; ks < 8; ++ks) Qf[ks] = *(const bf16x8*)(Q + qoff + ks * 16 + hh * 8);
            unsigned selmask = (1u << own) - 1u;
            if (own > 3) {
                f32x16 gacc;
#pragma unroll
                for (int j = 0; j < 16; ++j) gacc[j] = 0.f;
#pragma unroll
                for (int ks = 0; ks < 8; ++ks) {
                    u32x4 w = (u32x4){0u, 0u, 0u, 0u};
                    if (qr < 8) {
                        const float* kp = kpart + ((size_t)((b * 8 + qr) * 2)) * DM + h * 128 + ks * 16 + hh * 8;
                        const f32x4 a0 = *(const f32x4*)(kp), a1 = *(const f32x4*)(kp + 4), c0 = *(const f32x4*)(kp + DM), c1 = *(const f32x4*)(kp + DM + 4);
                        w = pack8((a0 + c0) * (1.0f / 256.0f), (a1 + c1) * (1.0f / 256.0f));
                    }
                    bf16x8 af; __builtin_memcpy(&af, &w, 16);
                    gacc = MFMA32(af, Qf[ks], gacc);
                }
                float gt[8];
#pragma unroll
                for (int j = 0; j < 4; ++j) { const float mine = gacc[j], oth = __shfl_xor(mine, 32); gt[j] = hh == 0 ? mine : oth; gt[4 + j] = hh == 0 ? oth : mine; }
#pragma unroll
                for (int j = 0; j < 8; ++j) if (j >= own) gt[j] = NEG;
                selmask = 0u;
#pragma unroll
                for (int r = 0; r < 3; ++r) {
                    float best = NEG; unsigned bi = 0u;
#pragma unroll
                    for (int j = 0; j < 8; ++j) { const bool take = !((selmask >> j) & 1u) && gt[j] > best; best = take ? gt[j] : best; bi = take ? (unsigned)j : bi; }
                    selmask |= 1u << bi;
                }
            }
            f32x16 O[4];
#pragma unroll
            for (int dt = 0; dt < 4; ++dt)
#pragma unroll
                for (int j = 0; j < 16; ++j) O[dt][j] = 0.f;
            float mrow = NEG, lsum = 0.f;
            __syncthreads();
            ATT_STORE(0);
            ATT_LOAD(1);
            asm volatile("s_waitcnt lgkmcnt(0)" ::: "memory"); __builtin_amdgcn_s_barrier(); asm volatile("" ::: "memory");
            for (int i = 0; i < ntile; ++i) {
                const int kt = i < 4 ? own * 4 + i : i - 4, buf = i & 1;
                const bool is_own = i < 4;
                const bool skip = is_own && (kt * 64 > q0 + 31);
                if (!skip) {
                    const LAS unsigned char* kb_ = lds + buf * KBUF;
                    const LAS unsigned char* vb_ = lds + 2 * KBUF + buf * VBUF;
                    f32x16 s0, s1;
                    const float sinit = (i == 0) ? 0.f : -mrow;
#pragma unroll
                    for (int j = 0; j < 16; ++j) { s0[j] = sinit; s1[j] = sinit; }
                    {
                        const LAS unsigned char* kp0 = kb_ + qr * KST + hh * 16; const LAS unsigned char* kp1 = kp0 + 32 * KST;
                        bf16x8 ka = *(const LAS bf16x8*)(kp0), kc = *(const LAS bf16x8*)(kp1);
#pragma unroll
                        for (int ks = 0; ks < 8; ++ks) {
                            bf16x8 na = ka, nc = kc;
                            if (ks < 7) { na = *(const LAS bf16x8*)(kp0 + (ks + 1) * 32); nc = *(const LAS bf16x8*)(kp1 + (ks + 1) * 32); }
                            __builtin_amdgcn_sched_barrier(0);
                            s0 = MFMA32(ka, Qf[ks], s0); s1 = MFMA32(kc, Qf[ks], s1);
                            __builtin_amdgcn_sched_barrier(0);
                            ka = na; kc = nc;
                        }
                    }
                    if (is_own) {
                        if (kt * 64 + 63 > q0) {
                            const int qpos = q0 + qr, kb0 = kt * 64 + hh * 4;
#pragma unroll
                            for (int j = 0; j < 16; ++j) { const int key = kb0 + (j >> 2) * 8 + (j & 3); if (key > qpos) s0[j] = NEG; if (key + 32 > qpos) s1[j] = NEG; }
                        }
                    } else if (!((selmask >> (kt >> 2)) & 1u)) {
#pragma unroll
                        for (int j = 0; j < 16; ++j) { s0[j] = NEG; s1[j] = NEG; }
                    }
                    if (i == 0) {
                        float mx = s0[0];
#pragma unroll
                        for (int j = 1; j < 16; ++j) mx = fmaxf(mx, s0[j]);
#pragma unroll
                        for (int j = 0; j < 16; ++j) mx = fmaxf(mx, s1[j]);
                        mx = fmaxf(mx, __shfl_xor(mx, 32));
                        mrow = mx;
#pragma unroll
                        for (int j = 0; j < 16; ++j) { s0[j] -= mx; s1[j] -= mx; }
                    }
                    float ps = 0.f;
#pragma unroll
                    for (int j = 0; j < 16; ++j) { s0[j] = __builtin_amdgcn_exp2f(s0[j]); s1[j] = __builtin_amdgcn_exp2f(s1[j]); ps += s0[j] + s1[j]; }
                    lsum += ps;
                    bf16x8 P[4];
                    { u32x4 w;
                      w.x = cvt_pk_bf16_t(s0[0], s0[1]); w.y = cvt_pk_bf16_t(s0[2], s0[3]); w.z = cvt_pk_bf16_t(s0[4], s0[5]); w.w = cvt_pk_bf16_t(s0[6], s0[7]); __builtin_memcpy(&P[0], &w, 16);
                      w.x = cvt_pk_bf16_t(s0[8], s0[9]); w.y = cvt_pk_bf16_t(s0[10], s0[11]); w.z = cvt_pk_bf16_t(s0[12], s0[13]); w.w = cvt_pk_bf16_t(s0[14], s0[15]); __builtin_memcpy(&P[1], &w, 16);
                      w.x = cvt_pk_bf16_t(s1[0], s1[1]); w.y = cvt_pk_bf16_t(s1[2], s1[3]); w.z = cvt_pk_bf16_t(s1[4], s1[5]); w.w = cvt_pk_bf16_t(s1[6], s1[7]); __builtin_memcpy(&P[2], &w, 16);
                      w.x = cvt_pk_bf16_t(s1[8], s1[9]); w.y = cvt_pk_bf16_t(s1[10], s1[11]); w.z = cvt_pk_bf16_t(s1[12], s1[13]); w.w = cvt_pk_bf16_t(s1[14], s1[15]); __builtin_memcpy(&P[3], &w, 16); }
                    {
                        const LAS unsigned char* vp = vb_ + qr * VSTR + hh * 16;
                        bf16x8 va = *(const LAS bf16x8*)(vp), vc = *(const LAS bf16x8*)(vp + 32);
#pragma unroll
                        for (int st = 0; st < 16; st += 2) {
                            const int dt = st >> 2, kk = st & 3;
                            bf16x8 na = va, nc = vc;
                            if (st < 14) { const int d2 = (st + 2) >> 2, k2 = (st + 2) & 3; na = *(const LAS bf16x8*)(vp + d2 * 32 * VSTR + k2 * 32); nc = *(const LAS bf16x8*)(vp + d2 * 32 * VSTR + (k2 + 1) * 32); }
                            __builtin_amdgcn_sched_barrier(0);
                            O[dt] = MFMA32(va, P[kk], O[dt]); O[dt] = MFMA32(vc, P[kk + 1], O[dt]);
                            __builtin_amdgcn_sched_barrier(0);
                            va = na; vc = nc;
                        }
                    }
                }
                if (i + 1 < ntile) ATT_STORE((i + 1) & 1);
                asm volatile("s_waitcnt lgkmcnt(0)" ::: "memory"); __builtin_amdgcn_s_barrier(); asm volatile("" ::: "memory");
                if (i + 2 < ntile) ATT_LOAD(i + 2);
            }
#undef ATT_LOAD
#undef ATT_STORE
            const float ltot = lsum + __shfl_xor(lsum, 32), inv = 1.0f / ltot;
#pragma unroll
            for (int dt = 0; dt < 4; ++dt)
#pragma unroll
                for (int i4 = 0; i4 < 4; ++i4) {
                    const size_t o = qoff + dt * 32 + i4 * 8 + hh * 4;
                    const u32x2 zw = *(const u32x2*)(Z + o);
                    u32x2 ow;
                    ow.x = cvt_pk_bf16(O[dt][4 * i4 + 0] * inv * bf_lo(zw.x), O[dt][4 * i4 + 1] * inv * bf_hi(zw.x));
                    ow.y = cvt_pk_bf16(O[dt][4 * i4 + 2] * inv * bf_lo(zw.y), O[dt][4 * i4 + 3] * inv * bf_hi(zw.y));
                    *(u32x2*)(Y + o) = ow;
                }
        }
    }
    __syncthreads();
}


#define XB_TMO      128
#define XB_XCNT(j)  (256  + 64 * (j))
#define XB_XSUB(j)  (1280 + 64 * (j))
#define XB_XGEN(j)  (2304 + 64 * (j))
#define XB_TOP      3328
#define XB_TOPGEN   3392
#define XCD_BAR_WORDS 3456
#define XB_SPIN_CAP (1u << 18)
__device__ __forceinline__ unsigned xb_ld(unsigned* p)              { return __hip_atomic_load(p, __ATOMIC_RELAXED, __HIP_MEMORY_SCOPE_AGENT); }
__device__ __forceinline__ unsigned xb_add(unsigned* p, unsigned v) { return __hip_atomic_fetch_add(p, v, __ATOMIC_RELAXED, __HIP_MEMORY_SCOPE_AGENT); }
__device__ __forceinline__ unsigned xb_xcc_id() { return (unsigned)__builtin_amdgcn_s_getreg((3 << 11) | 20) & 0xFu; }
#define XB_SPIN(cond, bar) do { unsigned _sp = 0; while (cond) { __builtin_amdgcn_s_sleep(1); \
    if ((++_sp & 255u) == 0u) { if (xb_ld(&(bar)[XB_TMO])) break; if (_sp > XB_SPIN_CAP) { atomicAdd(&(bar)[XB_TMO], 1u); break; } } } } while (0)
struct XcdBarrier { unsigned* bar; unsigned x; volatile LAS unsigned* st; };
__device__ __forceinline__ XcdBarrier xcd_barrier_post(unsigned* bar, volatile LAS unsigned* st) {
    XcdBarrier b; b.bar = bar; b.x = xb_xcc_id(); b.st = st;
    if (threadIdx.x == 0) (void)xb_add(&bar[XB_XCNT(b.x)], 1u);
    return b;
}
__device__ __forceinline__ void xcd_barrier_complete(unsigned* bar, unsigned x, unsigned& nloc, unsigned& nx) {
    const unsigned G = gridDim.x * gridDim.y * gridDim.z;
    unsigned sum, cnt, mine, sp = 0u;
    for (;;) {
        sum = 0u; cnt = 0u; mine = 0u;
#pragma unroll
        for (unsigned j = 0; j < 16; ++j) { const unsigned c = xb_ld(&bar[XB_XCNT(j)]); sum += c; cnt += (c > 0u) ? 1u : 0u; mine = (j == x) ? c : mine; }
        if (sum == G) break;
        __builtin_amdgcn_s_sleep(1);
        if ((++sp & 255u) == 0u) { if (xb_ld(&bar[XB_TMO])) break; if (sp > XB_SPIN_CAP) { atomicAdd(&bar[XB_TMO], 1u); break; } }
    }
    nloc = mine > 0u ? mine : 1u; nx = cnt > 0u ? cnt : 1u;
}
__device__ __forceinline__ void xcd_barrier(const XcdBarrier& b) {
    asm volatile("s_waitcnt vmcnt(0)" ::: "memory");
    __syncthreads();
    if (threadIdx.x == 0) {
        unsigned* bar = b.bar;
        __builtin_amdgcn_s_waitcnt(0);
        unsigned nloc = b.st[0], nx = b.st[1];
        if (nloc == 0u) { xcd_barrier_complete(bar, b.x, nloc, nx); b.st[0] = nloc; b.st[1] = nx; }
        const unsigned old = xb_add(&bar[XB_XSUB(b.x)], 1u);
        const unsigned gen = old / nloc;
        if (old + 1u == (gen + 1u) * nloc) {
            __builtin_amdgcn_fence(__ATOMIC_RELEASE, "agent");
            asm volatile("s_waitcnt vmcnt(0)" ::: "memory");
            const unsigned og = xb_add(&bar[XB_TOP], 1u);
            const unsigned tg = og / nx;
            if (og + 1u == (tg + 1u) * nx) xb_add(&bar[XB_TOPGEN], 1u);
            else XB_SPIN(xb_ld(&bar[XB_TOPGEN]) == tg, bar);
            __builtin_amdgcn_fence(__ATOMIC_ACQUIRE, "agent");
            xb_add(&bar[XB_XGEN(b.x)], 1u);
            asm volatile("s_waitcnt vmcnt(0)" ::: "memory");
        } else {
            XB_SPIN(xb_ld(&bar[XB_XGEN(b.x)]) == gen, bar);
            __builtin_amdgcn_fence(__ATOMIC_ACQUIRE, "agent");
            asm volatile("s_waitcnt vmcnt(0)" ::: "memory");
        }
    }
    __syncthreads();
}

constexpr int NPHASE = 11;
__global__ void __launch_bounds__(NTHREADS, 2) mk_fwd(Params P) {
    extern __shared__ __attribute__((aligned(16))) unsigned char lds_raw[];
    LAS unsigned char* lds = (LAS unsigned char*)lds_raw;
    cg::grid_group grid = cg::this_grid();
    const int G = gridDim.x, bid = blockIdx.x, lo = P.lo, hi = P.hi;
    unsigned char* ws = P.ws;
    bf16_t* WINB = (bf16_t*)(ws + WS_WINB); bf16_t* WOUT1 = (bf16_t*)(ws + WS_WOUT1); bf16_t* WG1 = (bf16_t*)(ws + WS_WG1); bf16_t* WP = (bf16_t*)(ws + WS_WP);
    bf16_t* PB = (bf16_t*)(ws + WS_PB); float* STATS = (float*)(ws + WS_STATS); float* KPART = (float*)(ws + WS_KPART); bf16_t* WSB = (bf16_t*)(ws + WS_WSB);
    bf16_t* SLOTA = (bf16_t*)(ws + WS_SLOTA); bf16_t* WINA = (bf16_t*)(ws + WS_WINA); bf16_t* WOUT0 = (bf16_t*)(ws + WS_WOUT0); bf16_t* WG0 = (bf16_t*)(ws + WS_WG0);
    bf16_t* Ub = (bf16_t*)(ws + WS_U); bf16_t* GVb = (bf16_t*)(ws + WS_GV); bf16_t* SZb = (bf16_t*)(ws + WS_SZ);
    bf16_t* Qb = (bf16_t*)(ws + WS_Q); bf16_t* Kb = (bf16_t*)(ws + WS_K); bf16_t* VTb = (bf16_t*)(ws + WS_VT); bf16_t* Zb = (bf16_t*)(ws + WS_Z);
    bf16_t* PP0 = (bf16_t*)(ws + WS_PP0); bf16_t* PP1 = (bf16_t*)(ws + WS_PP1); bf16_t* X1B = (bf16_t*)(ws + WS_X1B); bf16_t* X3B = (bf16_t*)(ws + WS_X3B); bf16_t* Y1 = (bf16_t*)P.out;
    const float ALPHA = 1.4142135623730951f;
#define IN(k) (lo <= (k) && (k) < hi)
    volatile LAS unsigned* xst = (volatile LAS unsigned*)(lds + LDS_MAIN);
    if (threadIdx.x == 0) { xst[0] = 0u; xst[1] = 0u; }
    __syncthreads();
    XcdBarrier xbar; xbar.bar = (unsigned*)(ws + WS_BAR); xbar.x = 0; xbar.st = xst;
    if (hi - lo > 1) xbar = xcd_barrier_post((unsigned*)(ws + WS_BAR), xst);
    if (hi > NPHASE) grid.sync();
#define SEAM(k) do { if (IN(k) && hi > (k) + 1) xcd_barrier(xbar); } while (0)

    if (IN(0)) {
        transpose_convert(lds, P.w_in_b, WINB, 2048, 8192, G, bid);
        transpose_convert(lds, P.w_out, WOUT0, 2048, 2048, G, bid);
        transpose_convert(lds, P.w_out + (size_t)2048 * 2048, WOUT1, 2048, 2048, G, bid);
        transpose_convert(lds, P.w_gate, WG0, 2048, 2048, G, bid);
        transpose_convert(lds, P.w_gate + (size_t)2048 * 2048, WG1, 2048, 2048, G, bid);
        transpose_convert(lds, P.w_proj, WP, 256, 2048, G, bid);
        transpose_convert(lds, P.w_proj + (size_t)256 * 2048, WP + (size_t)2048 * 256, 256, 2048, G, bid);
        convert_flat(P.p, PB, (size_t)2 * MTOK * 256, G, bid);
        for (int i = bid * NTHREADS + threadIdx.x; i < 16 * 128 * 128; i += G * NTHREADS) { const int s = i & 127, t = (i >> 7) & 127; WSB[i] = (bf16_t)(cvt_pk_bf16(s <= t ? P.w_s[i] : 0.f, 0.f) & 0xffffu); }
        transpose_convert<true>(lds, P.w_in_a, WINA, 2048, 6144, G, bid);
        convert_flat(P.x, SLOTA, (size_t)MTOK * DM, G, bid);
    }
    SEAM(0);
    if (IN(1)) {
        pg8::Gemm g{SLOTA, WINA, MTOK, 6144, 2048, 1 << 30, 0}; pg8::StaticOrder S; S.init(MTOK, 6144, G, bid);
        EpiL0In E{Ub, GVb, STATS};
        pg8::gemm_phase<EpiL0In, true>(lds, g, S, E);
    }
    SEAM(1);
    if (IN(2)) sgu_phase(lds, Ub, GVb, SZb, STATS, P.sgu_g, P.sgu_b, WSB, P.b_s, Y1, G, bid);
    SEAM(2);
    if (IN(3)) {
        { pg8::Gemm g{PB, WP, 2 * MTOK, 2048, 256, 32, 8}; pg8::StaticOrder S; S.init(2 * MTOK, 2048, G, bid);
          EpiPlain E{PP0, (long long)((WS_PP1 - WS_PP0) / 2)}; pg8::gemm_phase(lds, g, S, E); }
        { pg8::Gemm g{Y1, WOUT0, MTOK, 2048, 2048, 1 << 30, 0}; pg8::StaticOrder S; S.init(MTOK, 2048, G, bid);
          EpiResLn<true> E{SLOTA, X1B, P.ln_g, P.ln_b, ws, 0, 0}; pg8::gemm_phase(lds, g, S, E); }
    }
    SEAM(3);
    if (IN(5)) {
        pg8::Gemm g{X1B, WG0, MTOK, 2048, 2048, 1 << 30, 0}; pg8::StaticOrder S; S.init(MTOK, 2048, G, bid);
        EpiPle<false> E{X1B, PP0, SLOTA, nullptr}; pg8::gemm_phase<EpiPle<false>, true>(lds, g, S, E);
    }
    SEAM(5);
    if (IN(6)) {
        pg8::Gemm g{SLOTA, WINB, MTOK, 8192, 2048, 1 << 30, 0}; pg8::StaticOrder S; S.init(MTOK, 8192, G, bid);
        EpiL1In E{Qb, Kb, VTb, Zb, KPART}; pg8::gemm_phase<EpiL1In, true>(lds, g, S, E);
    }
    SEAM(6);
    if (IN(7)) attn_phase(lds, Qb, Kb, VTb, Zb, KPART, Y1, G, bid);
    SEAM(7);
    if (IN(8)) {
        { pg8::Gemm g{Y1, WOUT1, MTOK, 2048, 2048, 1 << 30, 0}; pg8::StaticOrder S; S.init(MTOK, 2048, G, bid);
          EpiResLn<true> E{SLOTA, X3B, P.ln_g + DM, P.ln_b + DM, ws, 1, 0}; pg8::gemm_phase(lds, g, S, E); }
    }
    SEAM(8);
    if (IN(10)) {
        pg8::Gemm g{X3B, WG1, MTOK, 2048, 2048, 1 << 30, 0}; pg8::StaticOrder S; S.init(MTOK, 2048, G, bid);
        EpiPle<true> E{X3B, PP1, nullptr, P.out}; pg8::gemm_phase<EpiPle<true>, true>(lds, g, S, E);
    }
#undef IN
#undef SEAM
}

extern "C" void kernel_launch(void* const* d_in, const int* in_sizes, int n_in, void* d_out, int out_size, void* d_ws, size_t ws_size, hipStream_t stream) {
    static int grid_blocks = 0;
    if (grid_blocks == 0) {
        if (n_in != 13 || out_size != MTOK * DM || ws_size < WS_END) { fprintf(stderr, "kernel_launch: unexpected shapes (n_in %d out %d ws %zu)\n", n_in, out_size, ws_size); grid_blocks = -1; return; }
        int dev = 0, cus = 0, per_cu = 0;
        hipGetDevice(&dev);
        hipDeviceGetAttribute(&cus, hipDeviceAttributeMultiprocessorCount, dev);
        if (hipFuncSetAttribute((const void*)mk_fwd, hipFuncAttributeMaxDynamicSharedMemorySize, LDS_BYTES) != hipSuccess) { fprintf(stderr, "kernel_launch: hipFuncSetAttribute failed\n"); grid_blocks = -1; return; }
        if (hipOccupancyMaxActiveBlocksPerMultiprocessor(&per_cu, (const void*)mk_fwd, NTHREADS, LDS_BYTES) != hipSuccess || per_cu < 1) { fprintf(stderr, "kernel_launch: occupancy query failed (%d)\n", per_cu); grid_blocks = -1; return; }
        grid_blocks = cus;
    }
    if (grid_blocks < 0) return;
    if (hipMemsetAsync((unsigned char*)d_ws + WS_BAR, 0, 16384 + 32768, stream) != hipSuccess) { fprintf(stderr, "kernel_launch: memset of the barrier words failed\n"); return; }
    Params p{};
    p.x = (const float*)d_in[0]; p.p = (const float*)d_in[1]; p.w_in_a = (const float*)d_in[2]; p.sgu_g = (const float*)d_in[3]; p.sgu_b = (const float*)d_in[4];
    p.w_s = (const float*)d_in[5]; p.b_s = (const float*)d_in[6]; p.w_in_b = (const float*)d_in[7]; p.w_out = (const float*)d_in[8]; p.ln_g = (const float*)d_in[9];
    p.ln_b = (const float*)d_in[10]; p.w_gate = (const float*)d_in[11]; p.w_proj = (const float*)d_in[12];
    p.out = (float*)d_out; p.ws = (unsigned char*)d_ws;
#if ONE_LAUNCH
    p.lo = 0; p.hi = NPHASE;
    void* args[] = {&p};
    hipError_t e = hipLaunchCooperativeKernel((const void*)mk_fwd, dim3(grid_blocks), dim3(NTHREADS), args, LDS_BYTES, stream);
    if (e != hipSuccess) fprintf(stderr, "cooperative launch failed: %s (grid %d)\n", hipGetErrorString(e), grid_blocks);
#else
    for (int k = 0; k < NPHASE; ++k) {
        p.lo = k; p.hi = k + 1;
        hipLaunchKernelGGL(mk_fwd, dim3(grid_blocks), dim3(NTHREADS), LDS_BYTES, stream, p);
    }
#endif
}
```

```cpp
#include <hip/hip_runtime.h>
#include <hip/hip_cooperative_groups.h>
#include <cstdio>
namespace cg = cooperative_groups;

#ifndef ONE_LAUNCH
#define ONE_LAUNCH 1
#endif

#define LAS __attribute__((address_space(3)))
typedef unsigned short bf16_t;
typedef short bf16x8 __attribute__((ext_vector_type(8)));
typedef float f32x4 __attribute__((ext_vector_type(4)));
typedef float f32x2 __attribute__((ext_vector_type(2)));
typedef float f32x16 __attribute__((ext_vector_type(16)));
typedef unsigned u32x4 __attribute__((ext_vector_type(4)));
typedef unsigned u32x2 __attribute__((ext_vector_type(2)));

constexpr int MTOK = 8192, DM = 2048, SEQ = 2048;
constexpr int NTHREADS = 512;
constexpr int LDS_MAIN = 131072, LDS_BYTES = LDS_MAIN + 16;
constexpr size_t TT = 33554432ull;
constexpr size_t WS_WINB = 0, WS_WOUT1 = TT, WS_WG1 = TT + TT / 4, WS_WP = TT + TT / 2, WS_PB = WS_WP + TT / 16, WS_MISC = WS_PB + TT / 4;
constexpr size_t WS_STATS = WS_MISC, WS_KPART = WS_MISC + (2u << 20), WS_WSB = WS_KPART + (512u << 10), WS_BAR = WS_WSB + (512u << 10), WS_CNT = WS_BAR + 16384, WS_SLOTS = WS_CNT + 32768;
constexpr size_t WS_SLOTA = 2 * TT, WS_WINA = 3 * TT, WS_WOUT0 = 3 * TT + 3 * (TT / 4), WS_WG0 = 4 * TT, WS_U = 4 * TT + TT / 4, WS_GV = WS_U + TT, WS_SZ = WS_GV + TT;
constexpr size_t WS_Q = 3 * TT, WS_K = 4 * TT, WS_VT = 5 * TT, WS_Z = 6 * TT, WS_PP1 = 7 * TT, WS_X3B = 4 * TT, WS_PP0 = WS_U, WS_X1B = WS_GV;
constexpr size_t WS_END = 8 * TT;
static_assert(WS_SZ + TT <= WS_END && WS_WSB + (512u << 10) <= WS_SLOTA && WS_GV == WS_U + TT && WS_SZ == WS_U + 2 * TT && WS_K == WS_Q + TT && WS_VT == WS_Q + 2 * TT && WS_Z == WS_Q + 3 * TT, "workspace map");

struct Params {
    const float* x; const float* p; const float* w_in_a; const float* sgu_g; const float* sgu_b; const float* w_s; const float* b_s; const float* w_in_b;
    const float* w_out; const float* ln_g; const float* ln_b; const float* w_gate; const float* w_proj;
    float* out; unsigned char* ws; int lo, hi;
};

__device__ __forceinline__ unsigned cvt_pk_bf16(float lo, float hi) { unsigned r; asm volatile("v_cvt_pk_bf16_f32 %0, %1, %2" : "=v"(r) : "v"(lo), "v"(hi)); return r; }
__device__ __forceinline__ unsigned cvt_pk_bf16_t(float lo, float hi) { unsigned r; asm volatile("s_nop 1\n\tv_cvt_pk_bf16_f32 %0, %1, %2" : "=v"(r) : "v"(lo), "v"(hi)); return r; }
__device__ __forceinline__ float bf_lo(unsigned w) { return __uint_as_float(w << 16); }
__device__ __forceinline__ float bf_hi(unsigned w) { return __uint_as_float(w & 0xffff0000u); }
__device__ __forceinline__ float fast_sigmoid(float v) { return __builtin_amdgcn_rcpf(1.0f + __builtin_amdgcn_exp2f(-1.4426950408889634f * v)); }
__device__ __forceinline__ float silu_f(float v) { return v * fast_sigmoid(v); }
__device__ __forceinline__ float gelu_f(float v) { const float u = 1.5957691216057308f * (v + 0.044715f * v * v * v); return v * fast_sigmoid(u); }

namespace pg8 {
constexpr int BM = 256, BK = 64, HALF = 128, HTB = HALF * BK * 2, STAGE_BYTES = 8 * HTB, NXCD = 8, WGM = 8;
__host__ __device__ __forceinline__ int lds_byte(int r, int c) { const int st = (r >> 4) * 2 + (c >> 5), rr = r & 15, cc = c & 31, ob = rr * 64 + cc * 2; return st * 1024 + (ob ^ (((ob >> 9) & 1) << 5)); }
__host__ __device__ __forceinline__ void stage_rc(int b, int& R, int& C) { const int st = b / 1024, sb = b % 1024, swz = sb ^ (((sb >> 9) & 1) << 5); R = (st >> 1) * 16 + swz / 64; C = (st & 1) * 32 + (swz % 64) / 2; }
__host__ __device__ __forceinline__ int perm32(int rho) { const int n = rho >> 4, i = rho & 15; return 8 * (i >> 2) + 4 * n + (i & 3); }
struct Unit { int pm, pn; };
struct Gemm { const bf16_t* A; const bf16_t* Bt; int M, N, K; int bsplit, badd; };
struct StaticOrder {
    int nM, nN, nwg, G, c;
    __device__ void init(int M, int N, int G_, int c_) { nM = M / BM; nN = N / BM; nwg = nM * nN; G = G_; c = c_; }
    __device__ bool next(int i, Unit& u) const {
        const long L = (long)i * G + c; if (L >= nwg) return false;
        int wgid = (int)L; { const int q = nwg / NXCD, r = nwg % NXCD, xcd = wgid % NXCD, off = wgid / NXCD; wgid = (xcd < r ? xcd * (q + 1) : r * (q + 1) + (xcd - r) * q) + off; }
        const int nig = WGM * nN, gid = wgid / nig, fm = gid * WGM, gsz = (nM - fm) < WGM ? (nM - fm) : WGM;
        u.pm = fm + ((wgid % nig) % gsz); u.pn = (wgid % nig) / gsz; return true;
    }
};
template <class Epi, bool ALIGN_EPI = false, bool SP2 = true>
__device__ __forceinline__ void gemm_phase(LAS unsigned char* lds, const Gemm g, const StaticOrder& S, const Epi& E) {
    const int tid = threadIdx.x, wid = __builtin_amdgcn_readfirstlane(tid >> 6), lane = tid & 63, wr = wid >> 2, wc = wid & 3, fr = lane & 15, fq = lane >> 4;
    const int K = g.K, nt = K / BK;
    unsigned voffA[2], voffB[2];
#pragma unroll
    for (int i = 0; i < 2; ++i) { int R, C; stage_rc(tid * 16 + i * 8192, R, C); const int Rb = (R & ~31) + perm32(R & 31);
        voffA[i] = (unsigned)(R * K + C) * 2u; voffB[i] = (unsigned)(Rb * K + C) * 2u; }
    const size_t kstep = (size_t)(BK * 2);
    const size_t hstep = (size_t)HALF * K * 2;
    const size_t tstep = 2 * hstep;
    const unsigned ldsw = (unsigned)wid * 1024u;
    const int aoff = lds_byte(wr * 64 + fr, fq * 8), boff = lds_byte(wc * 32 + fr, fq * 8);
#define PG8_SA(b, h) (((b) * 2 + (h)) * HTB)
#define PG8_SB(b, h) ((4 + (b) * 2 + (h)) * HTB)
#define PG8_STAGE(bufoff, gbase, voff) do { _Pragma("unroll") for (int _i = 0; _i < 2; ++_i) \
        __builtin_amdgcn_global_load_lds((const unsigned*)((const char*)(gbase) + (voff)[_i]), (LAS unsigned*)(lds + (bufoff) + ldsw + _i * 8192), 16, 0, 0); } while (0)
#define PG8_LDA(dst, b, h) do { _Pragma("unroll") for (int m = 0; m < 4; ++m) _Pragma("unroll") for (int k = 0; k < 2; ++k) dst[m][k] = *(const LAS bf16x8*)(lds + PG8_SA(b, h) + aoff + m * 2048 + k * 1024); } while (0)
#define PG8_LDB(dst, b, h) do { _Pragma("unroll") for (int n = 0; n < 2; ++n) _Pragma("unroll") for (int k = 0; k < 2; ++k) dst[n][k] = *(const LAS bf16x8*)(lds + PG8_SB(b, h) + boff + n * 2048 + k * 1024); } while (0)
#define PG8_MMA(ai, bj, At, Bt) do { __builtin_amdgcn_s_setprio(1); _Pragma("unroll") for (int m = 0; m < 4; ++m) _Pragma("unroll") for (int n = 0; n < 2; ++n) _Pragma("unroll") for (int k = 0; k < 2; ++k) \
        acc[ai][bj][m][n] = __builtin_amdgcn_mfma_f32_16x16x32_bf16(Bt[n][k], At[m][k], acc[ai][bj][m][n], 0, 0, 0); __builtin_amdgcn_s_setprio(0); } while (0)
#define PG8_WAIT_V(n) asm volatile("s_waitcnt vmcnt(" #n ")" ::: "memory")
#define PG8_WAIT_L(n) asm volatile("s_waitcnt lgkmcnt(" #n ")" ::: "memory")
#define PG8_BAR __builtin_amdgcn_s_barrier()
#define PG8_SCHED __builtin_amdgcn_sched_barrier(0)
    Unit cur, nxt; int ui = 0;
    if (!S.next(0, cur)) return;
    f32x4 acc[2][2][4][2];
#pragma unroll
    for (int a = 0; a < 2; ++a)
#pragma unroll
        for (int b = 0; b < 2; ++b)
#pragma unroll
            for (int m = 0; m < 4; ++m)
#pragma unroll
                for (int n = 0; n < 2; ++n) acc[a][b][m][n] = (f32x4){0.f, 0.f, 0.f, 0.f};
    bf16x8 At[4][2], B0[2][2], B1[2][2];
    const char* cA = (const char*)g.A + (size_t)cur.pm * tstep; const char* cB = (const char*)g.Bt + (size_t)(cur.pn + (cur.pm >= g.bsplit ? g.badd : 0)) * tstep;
    if constexpr (SP2) {
        PG8_STAGE(PG8_SB(0, 0), cB, voffB); PG8_STAGE(PG8_SB(0, 1), cB + hstep, voffB); PG8_STAGE(PG8_SA(0, 0), cA, voffA); PG8_STAGE(PG8_SA(0, 1), cA + hstep, voffA);
        if (wr == 1) PG8_BAR;
        PG8_WAIT_V(2); PG8_BAR;
        PG8_STAGE(PG8_SB(1, 0), cB + kstep, voffB); PG8_STAGE(PG8_SA(1, 0), cA + kstep, voffA); PG8_STAGE(PG8_SB(1, 1), cB + hstep + kstep, voffB);
        PG8_WAIT_V(6); PG8_BAR;
    } else {
        PG8_STAGE(PG8_SB(0, 0), cB, voffB); PG8_STAGE(PG8_SA(0, 0), cA, voffA); PG8_STAGE(PG8_SB(0, 1), cB + hstep, voffB); PG8_STAGE(PG8_SA(0, 1), cA + hstep, voffA);
        if (wr == 1) PG8_BAR;
        PG8_WAIT_V(4); PG8_BAR;
        PG8_STAGE(PG8_SB(1, 0), cB + kstep, voffB); PG8_STAGE(PG8_SA(1, 0), cA + kstep, voffA); PG8_STAGE(PG8_SB(1, 1), cB + hstep + kstep, voffB);
        PG8_WAIT_V(6); PG8_BAR;
    }
    for (;;) {
        const bool has_next = S.next(ui + 1, nxt);
        const char* nA = has_next ? (const char*)g.A + (size_t)nxt.pm * tstep : cA; const char* nB = has_next ? (const char*)g.Bt + (size_t)(nxt.pn + (nxt.pm >= g.bsplit ? g.badd : 0)) * tstep : cB;
        for (int t = 0; t < nt; t += 2) {
            const bool last = (t == nt - 2);
            const char* a1 = cA + (size_t)(t + 1) * kstep;
            const char* a2 = last ? nA : cA + (size_t)(t + 2) * kstep; const char* b2 = last ? nB : cB + (size_t)(t + 2) * kstep;
            const char* a3 = a2 + kstep; const char* b3 = b2 + kstep;
            if constexpr (SP2) {
            PG8_LDB(B0, 0, 0); PG8_LDB(B1, 0, 1); PG8_SCHED; PG8_LDA(At, 0, 0); PG8_STAGE(PG8_SA(1, 1), a1 + hstep, voffA);
            PG8_WAIT_V(8); PG8_WAIT_L(0); PG8_BAR; PG8_MMA(0, 0, At, B0); PG8_MMA(0, 1, At, B1); PG8_BAR; PG8_SCHED;
            PG8_LDA(At, 0, 1); PG8_STAGE(PG8_SB(0, 0), b2, voffB); PG8_STAGE(PG8_SB(0, 1), b2 + hstep, voffB); PG8_STAGE(PG8_SA(0, 0), a2, voffA);
            PG8_WAIT_V(8); PG8_WAIT_L(0); PG8_BAR; PG8_MMA(1, 0, At, B0); PG8_MMA(1, 1, At, B1); PG8_BAR; PG8_SCHED;
            PG8_LDB(B0, 1, 0); PG8_LDB(B1, 1, 1); PG8_SCHED; PG8_LDA(At, 1, 0); PG8_STAGE(PG8_SA(0, 1), a2 + hstep, voffA);
            PG8_WAIT_V(8); PG8_WAIT_L(0); PG8_BAR; PG8_MMA(0, 0, At, B0); PG8_MMA(0, 1, At, B1); PG8_BAR; PG8_SCHED;
            PG8_LDA(At, 1, 1); PG8_STAGE(PG8_SB(1, 0), b3, voffB); PG8_STAGE(PG8_SB(1, 1), b3 + hstep, voffB); PG8_STAGE(PG8_SA(1, 0), a3, voffA);
            PG8_WAIT_V(8); PG8_WAIT_L(0); PG8_BAR; PG8_MMA(1, 0, At, B0); PG8_MMA(1, 1, At, B1); PG8_BAR; PG8_SCHED;
            } else {
            PG8_LDB(B0, 0, 0); PG8_SCHED; PG8_LDA(At, 0, 0); PG8_STAGE(PG8_SA(1, 1), a1 + hstep, voffA);
            PG8_WAIT_L(8); PG8_BAR; PG8_WAIT_L(0); PG8_MMA(0, 0, At, B0); PG8_BAR; PG8_SCHED;
            PG8_LDB(B1, 0, 1); PG8_STAGE(PG8_SB(0, 0), b2, voffB);
            PG8_BAR; PG8_WAIT_L(0); PG8_MMA(0, 1, At, B1); PG8_BAR;
            PG8_LDA(At, 0, 1); PG8_STAGE(PG8_SA(0, 0), a2, voffA);
            PG8_BAR; PG8_WAIT_L(0); PG8_MMA(1, 0, At, B0); PG8_BAR; PG8_SCHED;
            PG8_STAGE(PG8_SB(0, 1), b2 + hstep, voffB);
            PG8_WAIT_V(6); PG8_BAR; PG8_MMA(1, 1, At, B1); PG8_BAR;
            PG8_LDB(B0, 1, 0); PG8_SCHED; PG8_LDA(At, 1, 0); PG8_STAGE(PG8_SA(0, 1), a2 + hstep, voffA);
            PG8_WAIT_L(8); PG8_BAR; PG8_WAIT_L(0); PG8_MMA(0, 0, At, B0); PG8_BAR; PG8_SCHED;
            PG8_LDB(B1, 1, 1); PG8_STAGE(PG8_SB(1, 0), b3, voffB);
            PG8_BAR; PG8_WAIT_L(0); PG8_MMA(0, 1, At, B1); PG8_BAR;
            PG8_LDA(At, 1, 1); PG8_STAGE(PG8_SA(1, 0), a3, voffA);
            PG8_BAR; PG8_WAIT_L(0); PG8_MMA(1, 0, At, B0); PG8_BAR; PG8_SCHED;
            PG8_STAGE(PG8_SB(1, 1), b3 + hstep, voffB);
            PG8_WAIT_V(6); PG8_BAR; PG8_MMA(1, 1, At, B1); PG8_BAR;
            }
        }
        if constexpr (ALIGN_EPI) { if (wr == 0) PG8_BAR; }
        if constexpr (!Epi::AFTER_DRAIN) E(acc, cur, wr, wc, fr, fq);
        if (!has_next) break;
#pragma unroll
        for (int a = 0; a < 2; ++a)
#pragma unroll
            for (int b = 0; b < 2; ++b)
#pragma unroll
                for (int m = 0; m < 4; ++m)
#pragma unroll
                    for (int n = 0; n < 2; ++n) acc[a][b][m][n] = (f32x4){0.f, 0.f, 0.f, 0.f};
        cur = nxt; cA = nA; cB = nB; ++ui;
        if constexpr (ALIGN_EPI) { if (wr == 1) PG8_BAR; }
    }
    PG8_WAIT_V(0);
    if constexpr (!ALIGN_EPI) { if (wr == 0) PG8_BAR; }
    PG8_BAR;
    if constexpr (Epi::AFTER_DRAIN) E.fused(acc, cur, wr, wc, fr, fq, lds, wid, lane);
#undef PG8_SA
#undef PG8_SB
#undef PG8_STAGE
#undef PG8_LDA
#undef PG8_LDB
#undef PG8_MMA
#undef PG8_WAIT_V
#undef PG8_WAIT_L
#undef PG8_BAR
#undef PG8_SCHED
}
}
using pg8::Unit;
typedef f32x4 Acc[2][2][4][2];

__device__ __forceinline__ u32x4 pack8(const f32x4 a, const f32x4 b) { u32x4 w; w.x = cvt_pk_bf16(a[0], a[1]); w.y = cvt_pk_bf16(a[2], a[3]); w.z = cvt_pk_bf16(b[0], b[1]); w.w = cvt_pk_bf16(b[2], b[3]); return w; }

struct EpiL0In {
    static constexpr bool AFTER_DRAIN = false;
    bf16_t* UZ; bf16_t* GV; float* stats;
    __device__ __forceinline__ void operator()(const Acc& acc, const Unit& u, int wr, int wc, int fr, int fq) const {
        if (u.pn < 16) {
            const int cb = u.pn * 128 + wc * 32 + 8 * fq;
#pragma unroll
            for (int ai = 0; ai < 2; ++ai)
#pragma unroll
                for (int m = 0; m < 4; ++m) {
                    const int row = u.pm * 256 + ai * 128 + wr * 64 + m * 16 + fr;
                    f32x4 a0 = acc[ai][0][m][0], a1 = acc[ai][0][m][1]; const f32x4 z0 = acc[ai][1][m][0], z1 = acc[ai][1][m][1];
#pragma unroll
                    for (int j = 0; j < 4; ++j) { a0[j] = gelu_f(a0[j]) * silu_f(z0[j]); a1[j] = gelu_f(a1[j]) * silu_f(z1[j]); }
                    *(u32x4*)(UZ + (size_t)row * DM + cb) = pack8(a0, a1);
                }
        } else {
            const int pnv = u.pn - 16, cb = pnv * 256 + wc * 32 + 8 * fq;
#pragma unroll
            for (int ai = 0; ai < 2; ++ai)
#pragma unroll
                for (int m = 0; m < 4; ++m) {
                    const int row = u.pm * 256 + ai * 128 + wr * 64 + m * 16 + fr;
                    float s = 0.f, ss = 0.f;
#pragma unroll
                    for (int bj = 0; bj < 2; ++bj) {
                        f32x4 v0 = acc[ai][bj][m][0], v1 = acc[ai][bj][m][1];
#pragma unroll
                        for (int j = 0; j < 4; ++j) { v0[j] = gelu_f(v0[j]); v1[j] = gelu_f(v1[j]); }
#pragma unroll
                        for (int j = 0; j < 4; ++j) { s += v0[j] + v1[j]; ss += v0[j] * v0[j] + v1[j] * v1[j]; }
                        *(u32x4*)(GV + (size_t)row * DM + cb + bj * 128) = pack8(v0, v1);
                    }
                    s += __shfl_xor(s, 16); s += __shfl_xor(s, 32); ss += __shfl_xor(ss, 16); ss += __shfl_xor(ss, 32);
                    if (fq == 0) *(f32x2*)(stats + ((size_t)row * 32 + pnv * 4 + wc) * 2) = (f32x2){s, ss};
                }
        }
    }
};
struct EpiPlain {
    static constexpr bool AFTER_DRAIN = false;
    bf16_t* O; long long delta2;
    __device__ __forceinline__ void operator()(const Acc& acc, const Unit& u, int wr, int wc, int fr, int fq) const {
        const int cb = u.pn * 256 + wc * 32 + 8 * fq;
        bf16_t* Ob = O + (u.pm >= 32 ? delta2 - (long long)32 * 256 * DM : 0ll);
#pragma unroll
        for (int ai = 0; ai < 2; ++ai)
#pragma unroll
            for (int m = 0; m < 4; ++m) {
                const int row = u.pm * 256 + ai * 128 + wr * 64 + m * 16 + fr;
#pragma unroll
                for (int bj = 0; bj < 2; ++bj) *(u32x4*)(Ob + (size_t)row * DM + cb + bj * 128) = pack8(acc[ai][bj][m][0], acc[ai][bj][m][1]);
            }
    }
};
struct EpiRes {
    static constexpr bool AFTER_DRAIN = false;
    const float* res; float* out; float* stats; float alpha;
    __device__ __forceinline__ void operator()(const Acc& acc, const Unit& u, int wr, int wc, int fr, int fq) const {
        const int cb = u.pn * 256 + wc * 32 + 8 * fq;
#pragma unroll
        for (int ai = 0; ai < 2; ++ai)
#pragma unroll
            for (int m = 0; m < 4; ++m) {
                const int row = u.pm * 256 + ai * 128 + wr * 64 + m * 16 + fr;
                float s = 0.f, ss = 0.f;
#pragma unroll
                for (int bj = 0; bj < 2; ++bj) {
                    const size_t o = (size_t)row * DM + cb + bj * 128;
                    const f32x4 r0 = *(const f32x4*)(res + o), r1 = *(const f32x4*)(res + o + 4);
                    const f32x4 t0 = r0 * alpha + acc[ai][bj][m][0], t1 = r1 * alpha + acc[ai][bj][m][1];
#pragma unroll
                    for (int j = 0; j < 4; ++j) { s += t0[j] + t1[j]; ss += t0[j] * t0[j] + t1[j] * t1[j]; }
                    *(f32x4*)(out + o) = t0; *(f32x4*)(out + o + 4) = t1;
                }
                s += __shfl_xor(s, 16); s += __shfl_xor(s, 32); ss += __shfl_xor(ss, 16); ss += __shfl_xor(ss, 32);
                if (fq == 0) *(f32x2*)(stats + ((size_t)row * 32 + u.pn * 4 + wc) * 2) = (f32x2){s, ss};
            }
    }
};
template <bool RES_BF16> struct EpiResLn {
    static constexpr bool AFTER_DRAIN = true;
    const void* res; bf16_t* xb; const float* g; const float* b; unsigned char* ws; int layer, pad;
    static constexpr float alpha = 1.4142135623730951f;
    __device__ __forceinline__ void operator()(const Acc&, const Unit&, int, int, int, int) const {}
    __device__ __forceinline__ void fused(Acc& acc, const Unit& u, int wr, int wc, int fr, int fq, LAS unsigned char* lds, int wid, int lane) const {
        const int cb = u.pn * 256 + wc * 32 + 8 * fq;
        LAS f32x2* Pt = (LAS f32x2*)lds;
        LAS f32x2* St = (LAS f32x2*)(lds + 8192);
        unsigned long long* slots = (unsigned long long*)(ws + WS_SLOTS) + (size_t)layer * MTOK * 8; unsigned* cnt = (unsigned*)(ws + WS_CNT) + layer * 64 * 32;
#pragma unroll
        for (int ai = 0; ai < 2; ++ai) {
            const size_t ob = (size_t)(u.pm * 256 + ai * 128 + wr * 64 + fr) * DM + cb;
            f32x4 rr[4][2][2];
#pragma unroll
            for (int m = 0; m < 4; ++m)
#pragma unroll
                for (int bj = 0; bj < 2; ++bj) {
                    const size_t o = ob + (size_t)m * 16 * DM + bj * 128;
                    if constexpr (RES_BF16) { const u32x4 rw = *(const u32x4*)((const bf16_t*)res + o);
                        rr[m][bj][0] = (f32x4){bf_lo(rw.x), bf_hi(rw.x), bf_lo(rw.y), bf_hi(rw.y)}; rr[m][bj][1] = (f32x4){bf_lo(rw.z), bf_hi(rw.z), bf_lo(rw.w), bf_hi(rw.w)}; }
                    else { rr[m][bj][0] = *(const f32x4*)((const float*)res + o); rr[m][bj][1] = *(const f32x4*)((const float*)res + o + 4); }
                }
#pragma unroll
            for (int m = 0; m < 4; ++m) {
                const int rl = ai * 128 + wr * 64 + m * 16 + fr;
                float s = 0.f, ss = 0.f;
#pragma unroll
                for (int bj = 0; bj < 2; ++bj) {
                    const f32x4 t0 = rr[m][bj][0] * alpha + acc[ai][bj][m][0], t1 = rr[m][bj][1] * alpha + acc[ai][bj][m][1];
                    acc[ai][bj][m][0] = t0; acc[ai][bj][m][1] = t1;
#pragma unroll
                    for (int j = 0; j < 4; ++j) { s += t0[j] + t1[j]; ss += t0[j] * t0[j] + t1[j] * t1[j]; }
                }
                s += __shfl_xor(s, 16); s += __shfl_xor(s, 32); ss += __shfl_xor(ss, 16); ss += __shfl_xor(ss, 32);
                if (fq == 0) Pt[rl * 4 + wc] = (f32x2){s, ss};
            }
        }
        asm volatile("s_waitcnt lgkmcnt(0)" ::: "memory"); __builtin_amdgcn_s_barrier(); asm volatile("" ::: "memory");
        const int rowi = wid * 32 + (lane & 31);
        if (lane < 32) {
            const f32x2 a = Pt[rowi * 4 + 0], b2 = Pt[rowi * 4 + 1], c = Pt[rowi * 4 + 2], d = Pt[rowi * 4 + 3];
            const float S = (a.x + b2.x) + (c.x + d.x), SS = (a.y + b2.y) + (c.y + d.y);
            unsigned long long* slot = slots + ((size_t)(u.pm * 256 + rowi) * 8 + u.pn);
            __hip_atomic_store(slot, ((unsigned long long)__float_as_uint(SS) << 32) | __float_as_uint(S), __ATOMIC_RELAXED, __HIP_MEMORY_SCOPE_AGENT);
        }
        asm volatile("s_waitcnt vmcnt(0)" ::: "memory");
        if (lane == 0) __hip_atomic_fetch_add(cnt + 64 * u.pm, 1u, __ATOMIC_RELAXED, __HIP_MEMORY_SCOPE_AGENT);
        if (wid == 0) {
            unsigned sp = 0u;
            while ((unsigned)__builtin_amdgcn_readfirstlane(__hip_atomic_load(cnt + 64 * u.pm, __ATOMIC_RELAXED, __HIP_MEMORY_SCOPE_AGENT)) < 64u) { __builtin_amdgcn_s_sleep(2); if (++sp > (1u << 22)) break; }
            __builtin_amdgcn_fence(__ATOMIC_ACQUIRE, "agent");
        }
        asm volatile("s_waitcnt vmcnt(0) lgkmcnt(0)" ::: "memory"); __builtin_amdgcn_s_barrier(); asm volatile("" ::: "memory");
        if (lane < 32) {
            const unsigned long long* slot = slots + (size_t)(u.pm * 256 + rowi) * 8; float S = 0.f, SS = 0.f;
#pragma unroll
            for (int t = 0; t < 8; ++t) { const unsigned long long w = __hip_atomic_load(slot + t, __ATOMIC_RELAXED, __HIP_MEMORY_SCOPE_AGENT); S += __uint_as_float((unsigned)w); SS += __uint_as_float((unsigned)(w >> 32)); }
            const float mean = S * (1.0f / DM), var = SS * (1.0f / DM) - mean * mean;
            St[rowi] = (f32x2){mean, rsqrtf(var + 1e-5f)};
        }
        asm volatile("s_waitcnt lgkmcnt(0)" ::: "memory"); __builtin_amdgcn_s_barrier(); asm volatile("" ::: "memory");
#pragma unroll
        for (int bj = 0; bj < 2; ++bj) {
            const f32x4 g0 = *(const f32x4*)(g + cb + bj * 128), g1 = *(const f32x4*)(g + cb + bj * 128 + 4), b0 = *(const f32x4*)(b + cb + bj * 128), b1 = *(const f32x4*)(b + cb + bj * 128 + 4);
#pragma unroll
            for (int ai = 0; ai < 2; ++ai)
#pragma unroll
                for (int m = 0; m < 4; ++m) {
                    const int rl = ai * 128 + wr * 64 + m * 16 + fr;
                    const f32x2 st = St[rl];
                    const size_t o = (size_t)(u.pm * 256 + rl) * DM + cb + bj * 128;
                    const f32x4 o0 = (acc[ai][bj][m][0] - st.x) * st.y * g0 + b0, o1 = (acc[ai][bj][m][1] - st.x) * st.y * g1 + b1;
                    *(u32x4*)(xb + o) = pack8(o0, o1);
                }
        }
    }
};
template <bool OUT_F32> struct EpiPle {
    static constexpr bool AFTER_DRAIN = false;
    const bf16_t* xin; const bf16_t* pp; bf16_t* xb; float* outf;
    __device__ __forceinline__ void operator()(const Acc& acc, const Unit& u, int wr, int wc, int fr, int fq) const {
        const int cb = u.pn * 256 + wc * 32 + 8 * fq;
#pragma unroll
        for (int ai = 0; ai < 2; ++ai) {
            const size_t o0 = (size_t)(u.pm * 256 + ai * 128 + wr * 64 + fr) * DM + cb;
            u32x4 xw[4][2], pw[4][2];
#pragma unroll
            for (int m = 0; m < 4; ++m)
#pragma unroll
                for (int bj = 0; bj < 2; ++bj) { const size_t o = o0 + (size_t)m * 16 * DM + bj * 128; xw[m][bj] = *(const u32x4*)(xin + o); pw[m][bj] = *(const u32x4*)(pp + o); }
#pragma unroll
            for (int m = 0; m < 4; ++m)
#pragma unroll
                for (int bj = 0; bj < 2; ++bj) {
                    const size_t o = o0 + (size_t)m * 16 * DM + bj * 128;
                    const u32x4 x = xw[m][bj], p = pw[m][bj];
                    const f32x4 a0 = acc[ai][bj][m][0], a1 = acc[ai][bj][m][1];
                    f32x4 r0, r1;
                    r0[0] = bf_lo(x.x) + fast_sigmoid(a0[0]) * bf_lo(p.x); r0[1] = bf_hi(x.x) + fast_sigmoid(a0[1]) * bf_hi(p.x);
                    r0[2] = bf_lo(x.y) + fast_sigmoid(a0[2]) * bf_lo(p.y); r0[3] = bf_hi(x.y) + fast_sigmoid(a0[3]) * bf_hi(p.y);
                    r1[0] = bf_lo(x.z) + fast_sigmoid(a1[0]) * bf_lo(p.z); r1[1] = bf_hi(x.z) + fast_sigmoid(a1[1]) * bf_hi(p.z);
                    r1[2] = bf_lo(x.w) + fast_sigmoid(a1[2]) * bf_lo(p.w); r1[3] = bf_hi(x.w) + fast_sigmoid(a1[3]) * bf_hi(p.w);
                    if constexpr (OUT_F32) { *(f32x4*)(outf + o) = r0; *(f32x4*)(outf + o + 4) = r1; }
                    else *(u32x4*)(xb + o) = pack8(r0, r1);
                }
        }
    }
};
struct EpiL1In {
    static constexpr bool AFTER_DRAIN = false;
    bf16_t* Q; bf16_t* Kb; bf16_t* VT; bf16_t* Z; float* kpart;
    __device__ __forceinline__ void operator()(const Acc& acc, const Unit& u, int wr, int wc, int fr, int fq) const {
        const int type = u.pn >> 3, cb = (u.pn & 7) * 256 + wc * 32 + 8 * fq;
        if (type == 2) {
            const int b = u.pm >> 3, sb = (u.pm & 7) * 256 + wr * 64;
            const int pos = (fr < 4 || fr >= 12) ? fr : (fr < 8 ? fr + 4 : fr - 4);
#pragma unroll
            for (int bj = 0; bj < 2; ++bj)
#pragma unroll
                for (int n = 0; n < 2; ++n)
#pragma unroll
                    for (int j = 0; j < 4; ++j) {
                        const int c = cb + bj * 128 + 4 * n + j, h = c >> 7, d = c & 127;
                        bf16_t* base = VT + ((size_t)((b * 16 + h) * 128 + d)) * SEQ + sb + pos;
#pragma unroll
                        for (int ai = 0; ai < 2; ++ai)
#pragma unroll
                            for (int m = 0; m < 4; ++m) base[ai * 128 + m * 16] = (bf16_t)(cvt_pk_bf16(acc[ai][bj][m][n][j], 0.f) & 0xffffu);
                    }
            return;
        }
        bf16_t* O = Q + (size_t)type * (TT / 2);
        const float qs = 0.08838834764831845f * 1.4426950408889634f;
#pragma unroll
        for (int ai = 0; ai < 2; ++ai)
#pragma unroll
            for (int m = 0; m < 4; ++m) {
                const int row = u.pm * 256 + ai * 128 + wr * 64 + m * 16 + fr;
#pragma unroll
                for (int bj = 0; bj < 2; ++bj) {
                    f32x4 v0 = acc[ai][bj][m][0], v1 = acc[ai][bj][m][1];
                    if (type == 0) { v0 *= qs; v1 *= qs; }
                    if (type == 3) {
#pragma unroll
                        for (int j = 0; j < 4; ++j) { v0[j] = silu_f(v0[j]); v1[j] = silu_f(v1[j]); }
                    }
                    *(u32x4*)(O + (size_t)row * DM + cb + bj * 128) = pack8(v0, v1);
                }
            }
        if (type == 1) {
            float* kp = kpart + ((size_t)(u.pm * 2 + wr)) * DM;
#pragma unroll
            for (int bj = 0; bj < 2; ++bj)
#pragma unroll
                for (int n = 0; n < 2; ++n) {
                    f32x4 cs = (f32x4){0.f, 0.f, 0.f, 0.f};
#pragma unroll
                    for (int ai = 0; ai < 2; ++ai)
#pragma unroll
                        for (int m = 0; m < 4; ++m) cs += acc[ai][bj][m][n];
#pragma unroll
                    for (int j = 0; j < 4; ++j) { float v = cs[j]; v += __shfl_xor(v, 1); v += __shfl_xor(v, 2); v += __shfl_xor(v, 4); v += __shfl_xor(v, 8); cs[j] = v; }
                    if (fr == 0) *(f32x4*)(kp + cb + bj * 128 + 4 * n) = cs;
                }
        }
    }
};

template <bool REMAP = false>
__device__ __forceinline__ void transpose_convert(LAS unsigned char* lds, const float* src, bf16_t* dst, int K, int N, int G, int bid) {
    LAS float* tile = (LAS float*)lds;
    const int tid = threadIdx.x, ntn = N / 64, ntiles = (K / 128) * ntn;
    const int r0 = tid >> 4, c4 = tid & 15;
    f32x4 v[4];
    if (bid < ntiles) { const int k0 = (bid / ntn) * 128, n0 = (bid % ntn) * 64;
#pragma unroll
        for (int i = 0; i < 4; ++i) v[i] = __builtin_nontemporal_load((const f32x4*)(src + (size_t)(k0 + r0 + 32 * i) * N + n0 + c4 * 4)); }
    for (int t = bid; t < ntiles; t += G) {
        const int k0 = (t / ntn) * 128, n0 = (t % ntn) * 64;
        asm volatile("s_waitcnt lgkmcnt(0)" ::: "memory"); __builtin_amdgcn_s_barrier(); asm volatile("" ::: "memory");
#pragma unroll
        for (int i = 0; i < 4; ++i) {
#pragma unroll
            for (int j = 0; j < 4; ++j) tile[(r0 + 32 * i) * 65 + c4 * 4 + j] = v[i][j]; }
        asm volatile("s_waitcnt lgkmcnt(0)" ::: "memory"); __builtin_amdgcn_s_barrier(); asm volatile("" ::: "memory");
        if (t + G < ntiles) { const int k1 = ((t + G) / ntn) * 128, n1 = ((t + G) % ntn) * 64;
#pragma unroll
            for (int i = 0; i < 4; ++i) v[i] = __builtin_nontemporal_load((const f32x4*)(src + (size_t)(k1 + r0 + 32 * i) * N + n1 + c4 * 4)); }
#pragma unroll
        for (int i = 0; i < 2; ++i) { const int id = tid + 512 * i, n = id >> 4, kc = id & 15;
            float f[8];
#pragma unroll
            for (int j = 0; j < 8; ++j) f[j] = tile[(kc * 8 + j) * 65 + n];
            u32x4 w; w.x = cvt_pk_bf16(f[0], f[1]); w.y = cvt_pk_bf16(f[2], f[3]); w.z = cvt_pk_bf16(f[4], f[5]); w.w = cvt_pk_bf16(f[6], f[7]);
            const int nd = !REMAP ? n0 : (n0 < 2048 ? (n0 >> 7) * 256 + (n0 & 127) : (n0 < 4096 ? n0 + 2048 : ((n0 - 4096) >> 7) * 256 + 128 + (n0 & 127)));
            *(u32x4*)(dst + (size_t)(nd + n) * K + k0 + kc * 8) = w; }
    }
    __syncthreads();
}
__device__ __forceinline__ void convert_flat(const float* src, bf16_t* dst, size_t n, int G, int bid) {
    const size_t n8 = n / 8, stride = (size_t)G * NTHREADS;
    size_t i = (size_t)bid * NTHREADS + threadIdx.x;
    for (; i + 3 * stride < n8; i += 4 * stride) {
        f32x4 a[4], b[4];
#pragma unroll
        for (int u = 0; u < 4; ++u) { a[u] = __builtin_nontemporal_load((const f32x4*)(src + (i + u * stride) * 8)); b[u] = __builtin_nontemporal_load((const f32x4*)(src + (i + u * stride) * 8 + 4)); }
#pragma unroll
        for (int u = 0; u < 4; ++u) *(u32x4*)(dst + (i + u * stride) * 8) = pack8(a[u], b[u]);
    }
    for (; i < n8; i += stride) {
        const f32x4 a = __builtin_nontemporal_load((const f32x4*)(src + i * 8)), b = __builtin_nontemporal_load((const f32x4*)(src + i * 8 + 4));
        *(u32x4*)(dst + i * 8) = pack8(a, b);
    }
}

__device__ __forceinline__ void ln_apply_phase(float* xf, const float* stats, const float* g, const float* bta, bf16_t* xb, int G, int bid) {
    const int wid = threadIdx.x >> 6, lane = threadIdx.x & 63;
    for (int row = bid * 8 + wid; row < MTOK; row += G * 8) {
        float s = 0.f, ss = 0.f;
        if (lane < 32) { const f32x2 pr = *(const f32x2*)(stats + ((size_t)row * 32 + lane) * 2); s = pr.x; ss = pr.y; }
#pragma unroll
        for (int o = 32; o >= 1; o >>= 1) { s += __shfl_xor(s, o); ss += __shfl_xor(ss, o); }
        const float mean = s * (1.0f / DM), var = ss * (1.0f / DM) - mean * mean, rstd = rsqrtf(var + 1e-5f);
        float* xr = xf + (size_t)row * DM;
#pragma unroll
        for (int i = 0; i < 4; ++i) {
            const int c = i * 512 + lane * 8;
            const f32x4 t0 = *(const f32x4*)(xr + c), t1 = *(const f32x4*)(xr + c + 4);
            const f32x4 g0 = *(const f32x4*)(g + c), g1 = *(const f32x4*)(g + c + 4), b0 = *(const f32x4*)(bta + c), b1 = *(const f32x4*)(bta + c + 4);
            const f32x4 o0 = (t0 - mean) * rstd * g0 + b0, o1 = (t1 - mean) * rstd * g1 + b1;
            *(f32x4*)(xr + c) = o0; *(f32x4*)(xr + c + 4) = o1;
            *(u32x4*)(xb + (size_t)row * DM + c) = pack8(o0, o1);
        }
    }
}

__device__ __forceinline__ void sgu_phase(LAS unsigned char* lds, const bf16_t* U, const bf16_t* GV, const bf16_t* SZ, const float* stats, const float* vg, const float* vb,
                                          const bf16_t* wsb, const float* b_s, bf16_t* Y, int G, int bid) {
    constexpr int VST = 272;
    LAS unsigned char* vnT = lds;
    LAS f32x2* rstat = (LAS f32x2*)(lds + 128 * VST);
    const int tid = threadIdx.x, wid = tid >> 6, lane = tid & 63, fr = lane & 15, fq = lane >> 4;
    for (int it = bid; it < 1024; it += G) {
        const int ci = it >> 4, g = it & 15, row0 = ci * 128;
        __syncthreads();
        if (tid < 128) {
            const float* sp = stats + (size_t)(row0 + tid) * 64; float s = 0.f, ss = 0.f;
#pragma unroll
            for (int i = 0; i < 16; ++i) { const f32x4 q = *(const f32x4*)(sp + i * 4); s += q[0] + q[2]; ss += q[1] + q[3]; }
            const float mean = s * (1.0f / DM), var = ss * (1.0f / DM) - mean * mean;
            rstat[tid] = (f32x2){mean, rsqrtf(var + 1e-5f)};
        }
        __syncthreads();
#pragma unroll
        for (int i = 0; i < 4; ++i) {
            const int id = tid + 512 * i, r = id >> 4, cc = id & 15;
            const u32x4 w = *(const u32x4*)(GV + (size_t)(row0 + r) * DM + g * 128 + cc * 8);
            const f32x2 st = rstat[r];
            const f32x4 g0 = *(const f32x4*)(vg + g * 128 + cc * 8), g1 = *(const f32x4*)(vg + g * 128 + cc * 8 + 4);
            const f32x4 b0 = *(const f32x4*)(vb + g * 128 + cc * 8), b1 = *(const f32x4*)(vb + g * 128 + cc * 8 + 4);
            float f[8] = {bf_lo(w.x), bf_hi(w.x), bf_lo(w.y), bf_hi(w.y), bf_lo(w.z), bf_hi(w.z), bf_lo(w.w), bf_hi(w.w)};
#pragma unroll
            for (int j = 0; j < 8; ++j) {
                const float gg = j < 4 ? g0[j & 3] : g1[j & 3], bb = j < 4 ? b0[j & 3] : b1[j & 3];
                const float vn = (f[j] - st.x) * st.y * gg + bb;
                *(LAS bf16_t*)(vnT + (cc * 8 + j) * VST + (((r >> 3) ^ cc) << 4) + (r & 7) * 2) = (bf16_t)(cvt_pk_bf16(vn, 0.f) & 0xffffu);
            }
        }
        __syncthreads();
        f32x4 acc[8];
#pragma unroll
        for (int ct = 0; ct < 8; ++ct) acc[ct] = (f32x4){0.f, 0.f, 0.f, 0.f};
        const bf16_t* wrow = wsb + ((size_t)g * 128 + wid * 16 + fr) * 128 + fq * 8;
        const int nks = (wid >> 1) + 1;
        for (int ks = 0; ks < nks; ++ks) {
            const bf16x8 wf = *(const bf16x8*)(wrow + ks * 32);
#pragma unroll
            for (int ct = 0; ct < 8; ++ct) {
                const bf16x8 vf = *(const LAS bf16x8*)(vnT + (ct * 16 + fr) * VST + (((ks * 4 + fq) ^ (ct * 2 + (fr >> 3))) << 4));
                acc[ct] = __builtin_amdgcn_mfma_f32_16x16x32_bf16(vf, wf, acc[ct], 0, 0, 0);
            }
        }
        const int t = wid * 16 + fr; const float bs = b_s[g * 128 + t];
        const size_t ro = (size_t)(row0 + t) * DM + g * 128 + 4 * fq;
#pragma unroll
        for (int ct = 0; ct < 8; ++ct) {
            const u32x2 uw = *(const u32x2*)(U + ro + ct * 16);
            const float y0 = bf_lo(uw.x) * (acc[ct][0] + bs), y1 = bf_hi(uw.x) * (acc[ct][1] + bs);
            const float y2 = bf_lo(uw.y) * (acc[ct][2] + bs), y3 = bf_hi(uw.y) * (acc[ct][3] + bs);
            u32x2 o; o.x = cvt_pk_bf16(y0, y1); o.y = cvt_pk_bf16(y2, y3);
            *(u32x2*)(Y + ro + ct * 16) = o;
        }
    }
    __syncthreads();
}

#define MFMA32(a, b, c) __builtin_amdgcn_mfma_f32_32x32x16_bf16((a), (b), (c), 0, 0, 0)
__device__ __forceinline__ void attn_phase(LAS unsigned char* lds, const bf16_t* Q, const bf16_t* Kb, const bf16_t* VT, const bf16_t* Z, const float* kpart, bf16_t* Y, int G, int bid) {
    constexpr int KST = 272, VSTR = 144, KBUF = 64 * KST, VBUF = 128 * VSTR;
    const int tid = threadIdx.x, wid = __builtin_amdgcn_readfirstlane(tid >> 6), lane = tid & 63, qr = lane & 31, hh = lane >> 5;
    const float NEG = -__builtin_inff();
    for (int pair = bid; pair < 256; pair += G) {
        const int bh = pair >> 2, jp = pair & 3, b = bh >> 4, h = bh & 15;
        for (int half = 0; half < 2; ++half) {
            const int own = half == 0 ? 7 - jp : jp;
            const int q0 = own * 256 + wid * 32;
            const size_t qoff = (size_t)(b * SEQ + q0 + qr) * DM + h * 128;
            bf16x8 Qf[8];
#pragma unroll
            for (int ks = 0; ks < 8; ++ks) Qf[ks] = *(const bf16x8*)(Q + qoff + ks * 16 + hh * 8);
            unsigned selmask = (1u << own) - 1u;
            if (own > 3) {
                f32x16 gacc;
#pragma unroll
                for (int j = 0; j < 16; ++j) gacc[j] = 0.f;
#pragma unroll
                for (int ks = 0; ks < 8; ++ks) {
                    u32x4 w = (u32x4){0u, 0u, 0u, 0u};
                    if (qr < 8) {
                        const float* kp = kpart + ((size_t)((b * 8 + qr) * 2)) * DM + h * 128 + ks * 16 + hh * 8;
                        const f32x4 a0 = *(const f32x4*)(kp), a1 = *(const f32x4*)(kp + 4), c0 = *(const f32x4*)(kp + DM), c1 = *(const f32x4*)(kp + DM + 4);
                        w = pack8((a0 + c0) * (1.0f / 256.0f), (a1 + c1) * (1.0f / 256.0f));
                    }
                    bf16x8 af; __builtin_memcpy(&af, &w, 16);
                    gacc = MFMA32(af, Qf[ks], gacc);
                }
                float gt[8];
#pragma unroll
                for (int j = 0; j < 4; ++j) { const float mine = gacc[j], oth = __shfl_xor(mine, 32); gt[j] = hh == 0 ? mine : oth; gt[4 + j] = hh == 0 ? oth : mine; }
#pragma unroll
                for (int j = 0; j < 8; ++j) if (j >= own) gt[j] = NEG;
                selmask = 0u;
#pragma unroll
                for (int r = 0; r < 3; ++r) {
                    float best = NEG; unsigned bi = 0u;
#pragma unroll
                    for (int j = 0; j < 8; ++j) { const bool take = !((selmask >> j) & 1u) && gt[j] > best; best = take ? gt[j] : best; bi = take ? (unsigned)j : bi; }
                    selmask |= 1u << bi;
                }
            }
            f32x16 O[4];
#pragma unroll
            for (int dt = 0; dt < 4; ++dt)
#pragma unroll
                for (int j = 0; j < 16; ++j) O[dt][j] = 0.f;
            float mrow = NEG, lsum = 0.f;
            const int ntile = (own + 1) * 4;
            const bf16_t* kg = Kb + (size_t)(b * SEQ) * DM + h * 128;
            const bf16_t* vg = VT + (size_t)((b * 16 + h) * 128) * SEQ;
            u32x4 kreg[2], vreg[2];
#define ATT_LOAD(i_) do { const int _i = (i_); const int _kt = _i < 4 ? own * 4 + _i : _i - 4; \
                _Pragma("unroll") for (int c2 = 0; c2 < 2; ++c2) { const int id = tid + 512 * c2; \
                    kreg[c2] = *(const u32x4*)(kg + (size_t)(_kt * 64 + (id >> 4)) * DM + (id & 15) * 8); \
                    vreg[c2] = *(const u32x4*)(vg + (size_t)(id >> 3) * SEQ + _kt * 64 + (id & 7) * 8); } } while (0)
#define ATT_STORE(buf_) do { _Pragma("unroll") for (int c2 = 0; c2 < 2; ++c2) { const int id = tid + 512 * c2; \
                    *(LAS u32x4*)(lds + (buf_) * KBUF + (id >> 4) * KST + (id & 15) * 16) = kreg[c2]; \
                    *(LAS u32x4*)(lds + 2 * KBUF + (buf_) * VBUF + (id >> 3) * VSTR + (id & 7) * 16) = vreg[c2]; } } while (0)
            ATT_LOAD(0);
            __syncthreads();
            ATT_STORE(0);
            ATT_LOAD(1);
            __syncthreads();
            for (int i = 0; i < ntile; ++i) {
                const int kt = i < 4 ? own * 4 + i : i - 4, buf = i & 1;
                const bool is_own = i < 4;
                const bool skip = is_own && (kt * 64 > q0 + 31);
                if (!skip) {
                    const LAS unsigned char* kb_ = lds + buf * KBUF;
                    const LAS unsigned char* vb_ = lds + 2 * KBUF + buf * VBUF;
                    f32x16 s0, s1;
                    const float sinit = (i == 0) ? 0.f : -mrow;
#pragma unroll
                    for (int j = 0; j < 16; ++j) { s0[j] = sinit; s1[j] = sinit; }
                    {
                        const LAS unsigned char* kp0 = kb_ + qr * KST + hh * 16; const LAS unsigned char* kp1 = kp0 + 32 * KST;
                        bf16x8 ka = *(const LAS bf16x8*)(kp0), kc = *(const LAS bf16x8*)(kp1);
#pragma unroll
                        for (int ks = 0; ks < 8; ++ks) {
                            bf16x8 na = ka, nc = kc;
                            if (ks < 7) { na = *(const LAS bf16x8*)(kp0 + (ks + 1) * 32); nc = *(const LAS bf16x8*)(kp1 + (ks + 1) * 32); }
                            __builtin_amdgcn_sched_barrier(0);
                            s0 = MFMA32(ka, Qf[ks], s0); s1 = MFMA32(kc, Qf[ks], s1);
                            __builtin_amdgcn_sched_barrier(0);
                            ka = na; kc = nc;
                        }
                    }
                    if (is_own) {
                        if (kt * 64 + 63 > q0) {
                            const int qpos = q0 + qr, kb0 = kt * 64 + hh * 4;
#pragma unroll
                            for (int j = 0; j < 16; ++j) { const int key = kb0 + (j >> 2) * 8 + (j & 3); if (key > qpos) s0[j] = NEG; if (key + 32 > qpos) s1[j] = NEG; }
                        }
                    } else if (!((selmask >> (kt >> 2)) & 1u)) {
#pragma unroll
                        for (int j = 0; j < 16; ++j) { s0[j] = NEG; s1[j] = NEG; }
                    }
                    if (i == 0) {
                        float mx = s0[0];
#pragma unroll
                        for (int j = 1; j < 16; ++j) mx = fmaxf(mx, s0[j]);
#pragma unroll
                        for (int j = 0; j < 16; ++j) mx = fmaxf(mx, s1[j]);
                        mx = fmaxf(mx, __shfl_xor(mx, 32));
                        mrow = mx;
#pragma unroll
                        for (int j = 0; j < 16; ++j) { s0[j] -= mx; s1[j] -= mx; }
                    }
                    float ps = 0.f;
#pragma unroll
                    for (int j = 0; j < 16; ++j) { s0[j] = __builtin_amdgcn_exp2f(s0[j]); s1[j] = __builtin_amdgcn_exp2f(s1[j]); ps += s0[j] + s1[j]; }
                    lsum += ps;
                    bf16x8 P[4];
                    { u32x4 w;
                      w.x = cvt_pk_bf16_t(s0[0], s0[1]); w.y = cvt_pk_bf16_t(s0[2], s0[3]); w.z = cvt_pk_bf16_t(s0[4], s0[5]); w.w = cvt_pk_bf16_t(s0[6], s0[7]); __builtin_memcpy(&P[0], &w, 16);
                      w.x = cvt_pk_bf16_t(s0[8], s0[9]); w.y = cvt_pk_bf16_t(s0[10], s0[11]); w.z = cvt_pk_bf16_t(s0[12], s0[13]); w.w = cvt_pk_bf16_t(s0[14], s0[15]); __builtin_memcpy(&P[1], &w, 16);
                      w.x = cvt_pk_bf16_t(s1[0], s1[1]); w.y = cvt_pk_bf16_t(s1[2], s1[3]); w.z = cvt_pk_bf16_t(s1[4], s1[5]); w.w = cvt_pk_bf16_t(s1[6], s1[7]); __builtin_memcpy(&P[2], &w, 16);
                      w.x = cvt_pk_bf16_t(s1[8], s1[9]); w.y = cvt_pk_bf16_t(s1[10], s1[11]); w.z = cvt_pk_bf16_t(s1[12], s1[13]); w.w = cvt_pk_bf16_t(s1[14], s1[15]); __builtin_memcpy(&P[3], &w, 16); }
                    {
                        const LAS unsigned char* vp = vb_ + qr * VSTR + hh * 16;
                        bf16x8 va = *(const LAS bf16x8*)(vp), vc = *(const LAS bf16x8*)(vp + 32);
#pragma unroll
                        for (int st = 0; st < 16; st += 2) {
                            const int dt = st >> 2, kk = st & 3;
                            bf16x8 na = va, nc = vc;
                            if (st < 14) { const int d2 = (st + 2) >> 2, k2 = (st + 2) & 3; na = *(const LAS bf16x8*)(vp + d2 * 32 * VSTR + k2 * 32); nc = *(const LAS bf16x8*)(vp + d2 * 32 * VSTR + (k2 + 1) * 32); }
                            __builtin_amdgcn_sched_barrier(0);
                            O[dt] = MFMA32(va, P[kk], O[dt]); O[dt] = MFMA32(vc, P[kk + 1], O[dt]);
                            __builtin_amdgcn_sched_barrier(0);
                            va = na; vc = nc;
                        }
                    }
                }
                if (i + 1 < ntile) ATT_STORE((i + 1) & 1);
                asm volatile("s_waitcnt lgkmcnt(0)" ::: "memory"); __builtin_amdgcn_s_barrier(); asm volatile("" ::: "memory");
                if (i + 2 < ntile) ATT_LOAD(i + 2);
            }
#undef ATT_LOAD
#undef ATT_STORE
            const float ltot = lsum + __shfl_xor(lsum, 32), inv = 1.0f / ltot;
#pragma unroll
            for (int dt = 0; dt < 4; ++dt)
#pragma unroll
                for (int i4 = 0; i4 < 4; ++i4) {
                    const size_t o = qoff + dt * 32 + i4 * 8 + hh * 4;
                    const u32x2 zw = *(const u32x2*)(Z + o);
                    u32x2 ow;
                    ow.x = cvt_pk_bf16(O[dt][4 * i4 + 0] * inv * bf_lo(zw.x), O[dt][4 * i4 + 1] * inv * bf_hi(zw.x));
                    ow.y = cvt_pk_bf16(O[dt][4 * i4 + 2] * inv * bf_lo(zw.y), O[dt][4 * i4 + 3] * inv * bf_hi(zw.y));
                    *(u32x2*)(Y + o) = ow;
                }
        }
    }
    __syncthreads();
}


#define XB_TMO      128
#define XB_XCNT(j)  (256  + 64 * (j))
#define XB_XSUB(j)  (1280 + 64 * (j))
#define XB_XGEN(j)  (2304 + 64 * (j))
#define XB_TOP      3328
#define XB_TOPGEN   3392
#define XCD_BAR_WORDS 3456
#define XB_SPIN_CAP (1u << 18)
__device__ __forceinline__ unsigned xb_ld(unsigned* p)              { return __hip_atomic_load(p, __ATOMIC_RELAXED, __HIP_MEMORY_SCOPE_AGENT); }
__device__ __forceinline__ unsigned xb_add(unsigned* p, unsigned v) { return __hip_atomic_fetch_add(p, v, __ATOMIC_RELAXED, __HIP_MEMORY_SCOPE_AGENT); }
__device__ __forceinline__ unsigned xb_xcc_id() { return (unsigned)__builtin_amdgcn_s_getreg((3 << 11) | 20) & 0xFu; }
#define XB_SPIN(cond, bar) do { unsigned _sp = 0; while (cond) { __builtin_amdgcn_s_sleep(1); \
    if ((++_sp & 255u) == 0u) { if (xb_ld(&(bar)[XB_TMO])) break; if (_sp > XB_SPIN_CAP) { atomicAdd(&(bar)[XB_TMO], 1u); break; } } } } while (0)
struct XcdBarrier { unsigned* bar; unsigned x; volatile LAS unsigned* st; };
__device__ __forceinline__ XcdBarrier xcd_barrier_post(unsigned* bar, volatile LAS unsigned* st) {
    XcdBarrier b; b.bar = bar; b.x = xb_xcc_id(); b.st = st;
    if (threadIdx.x == 0) (void)xb_add(&bar[XB_XCNT(b.x)], 1u);
    return b;
}
__device__ __forceinline__ void xcd_barrier_complete(unsigned* bar, unsigned x, unsigned& nloc, unsigned& nx) {
    const unsigned G = gridDim.x * gridDim.y * gridDim.z;
    unsigned sum, cnt, mine, sp = 0u;
    for (;;) {
        sum = 0u; cnt = 0u; mine = 0u;
#pragma unroll
        for (unsigned j = 0; j < 16; ++j) { const unsigned c = xb_ld(&bar[XB_XCNT(j)]); sum += c; cnt += (c > 0u) ? 1u : 0u; mine = (j == x) ? c : mine; }
        if (sum == G) break;
        __builtin_amdgcn_s_sleep(1);
        if ((++sp & 255u) == 0u) { if (xb_ld(&bar[XB_TMO])) break; if (sp > XB_SPIN_CAP) { atomicAdd(&bar[XB_TMO], 1u); break; } }
    }
    nloc = mine > 0u ? mine : 1u; nx = cnt > 0u ? cnt : 1u;
}
__device__ __forceinline__ void xcd_barrier(const XcdBarrier& b) {
    asm volatile("s_waitcnt vmcnt(0)" ::: "memory");
    __syncthreads();
    if (threadIdx.x == 0) {
        unsigned* bar = b.bar;
        __builtin_amdgcn_s_waitcnt(0);
        unsigned nloc = b.st[0], nx = b.st[1];
        if (nloc == 0u) { xcd_barrier_complete(bar, b.x, nloc, nx); b.st[0] = nloc; b.st[1] = nx; }
        const unsigned old = xb_add(&bar[XB_XSUB(b.x)], 1u);
        const unsigned gen = old / nloc;
        if (old + 1u == (gen + 1u) * nloc) {
            __builtin_amdgcn_fence(__ATOMIC_RELEASE, "agent");
            asm volatile("s_waitcnt vmcnt(0)" ::: "memory");
            const unsigned og = xb_add(&bar[XB_TOP], 1u);
            const unsigned tg = og / nx;
            if (og + 1u == (tg + 1u) * nx) xb_add(&bar[XB_TOPGEN], 1u);
            else XB_SPIN(xb_ld(&bar[XB_TOPGEN]) == tg, bar);
            __builtin_amdgcn_fence(__ATOMIC_ACQUIRE, "agent");
            xb_add(&bar[XB_XGEN(b.x)], 1u);
            asm volatile("s_waitcnt vmcnt(0)" ::: "memory");
        } else {
            XB_SPIN(xb_ld(&bar[XB_XGEN(b.x)]) == gen, bar);
            __builtin_amdgcn_fence(__ATOMIC_ACQUIRE, "agent");
            asm volatile("s_waitcnt vmcnt(0)" ::: "memory");
        }
    }
    __syncthreads();
}

constexpr int NPHASE = 11;
__global__ void __launch_bounds__(NTHREADS, 2) mk_fwd(Params P) {
    extern __shared__ __attribute__((aligned(16))) unsigned char lds_raw[];
    LAS unsigned char* lds = (LAS unsigned char*)lds_raw;
    cg::grid_group grid = cg::this_grid();
    const int G = gridDim.x, bid = blockIdx.x, lo = P.lo, hi = P.hi;
    unsigned char* ws = P.ws;
    bf16_t* WINB = (bf16_t*)(ws + WS_WINB); bf16_t* WOUT1 = (bf16_t*)(ws + WS_WOUT1); bf16_t* WG1 = (bf16_t*)(ws + WS_WG1); bf16_t* WP = (bf16_t*)(ws + WS_WP);
    bf16_t* PB = (bf16_t*)(ws + WS_PB); float* STATS = (float*)(ws + WS_STATS); float* KPART = (float*)(ws + WS_KPART); bf16_t* WSB = (bf16_t*)(ws + WS_WSB);
    bf16_t* SLOTA = (bf16_t*)(ws + WS_SLOTA); bf16_t* WINA = (bf16_t*)(ws + WS_WINA); bf16_t* WOUT0 = (bf16_t*)(ws + WS_WOUT0); bf16_t* WG0 = (bf16_t*)(ws + WS_WG0);
    bf16_t* Ub = (bf16_t*)(ws + WS_U); bf16_t* GVb = (bf16_t*)(ws + WS_GV); bf16_t* SZb = (bf16_t*)(ws + WS_SZ);
    bf16_t* Qb = (bf16_t*)(ws + WS_Q); bf16_t* Kb = (bf16_t*)(ws + WS_K); bf16_t* VTb = (bf16_t*)(ws + WS_VT); bf16_t* Zb = (bf16_t*)(ws + WS_Z);
    bf16_t* PP0 = (bf16_t*)(ws + WS_PP0); bf16_t* PP1 = (bf16_t*)(ws + WS_PP1); bf16_t* X1B = (bf16_t*)(ws + WS_X1B); bf16_t* X3B = (bf16_t*)(ws + WS_X3B); bf16_t* Y1 = (bf16_t*)P.out;
    const float ALPHA = 1.4142135623730951f;
#define IN(k) (lo <= (k) && (k) < hi)
    volatile LAS unsigned* xst = (volatile LAS unsigned*)(lds + LDS_MAIN);
    if (threadIdx.x == 0) { xst[0] = 0u; xst[1] = 0u; }
    __syncthreads();
    XcdBarrier xbar; xbar.bar = (unsigned*)(ws + WS_BAR); xbar.x = 0; xbar.st = xst;
    if (hi - lo > 1) xbar = xcd_barrier_post((unsigned*)(ws + WS_BAR), xst);
    if (hi > NPHASE) grid.sync();
#define SEAM(k) do { if (IN(k) && hi > (k) + 1) xcd_barrier(xbar); } while (0)

    if (IN(0)) {
        transpose_convert(lds, P.w_in_b, WINB, 2048, 8192, G, bid);
        transpose_convert(lds, P.w_out, WOUT0, 2048, 2048, G, bid);
        transpose_convert(lds, P.w_out + (size_t)2048 * 2048, WOUT1, 2048, 2048, G, bid);
        transpose_convert(lds, P.w_gate, WG0, 2048, 2048, G, bid);
        transpose_convert(lds, P.w_gate + (size_t)2048 * 2048, WG1, 2048, 2048, G, bid);
        transpose_convert(lds, P.w_proj, WP, 256, 2048, G, bid);
        transpose_convert(lds, P.w_proj + (size_t)256 * 2048, WP + (size_t)2048 * 256, 256, 2048, G, bid);
        convert_flat(P.p, PB, (size_t)2 * MTOK * 256, G, bid);
        for (int i = bid * NTHREADS + threadIdx.x; i < 16 * 128 * 128; i += G * NTHREADS) { const int s = i & 127, t = (i >> 7) & 127; WSB[i] = (bf16_t)(cvt_pk_bf16(s <= t ? P.w_s[i] : 0.f, 0.f) & 0xffffu); }
        transpose_convert<true>(lds, P.w_in_a, WINA, 2048, 6144, G, bid);
        convert_flat(P.x, SLOTA, (size_t)MTOK * DM, G, bid);
    }
    SEAM(0);
    if (IN(1)) {
        pg8::Gemm g{SLOTA, WINA, MTOK, 6144, 2048, 1 << 30, 0}; pg8::StaticOrder S; S.init(MTOK, 6144, G, bid);
        EpiL0In E{Ub, GVb, STATS};
        pg8::gemm_phase<EpiL0In, true>(lds, g, S, E);
    }
    SEAM(1);
    if (IN(2)) sgu_phase(lds, Ub, GVb, SZb, STATS, P.sgu_g, P.sgu_b, WSB, P.b_s, Y1, G, bid);
    SEAM(2);
    if (IN(3)) {
        { pg8::Gemm g{PB, WP, 2 * MTOK, 2048, 256, 32, 8}; pg8::StaticOrder S; S.init(2 * MTOK, 2048, G, bid);
          EpiPlain E{PP0, (long long)((WS_PP1 - WS_PP0) / 2)}; pg8::gemm_phase(lds, g, S, E); }
        { pg8::Gemm g{Y1, WOUT0, MTOK, 2048, 2048, 1 << 30, 0}; pg8::StaticOrder S; S.init(MTOK, 2048, G, bid);
          EpiResLn<true> E{SLOTA, X1B, P.ln_g, P.ln_b, ws, 0, 0}; pg8::gemm_phase(lds, g, S, E); }
    }
    SEAM(3);
    if (IN(5)) {
        pg8::Gemm g{X1B, WG0, MTOK, 2048, 2048, 1 << 30, 0}; pg8::StaticOrder S; S.init(MTOK, 2048, G, bid);
        EpiPle<false> E{X1B, PP0, SLOTA, nullptr}; pg8::gemm_phase<EpiPle<false>, true>(lds, g, S, E);
    }
    SEAM(5);
    if (IN(6)) {
        pg8::Gemm g{SLOTA, WINB, MTOK, 8192, 2048, 1 << 30, 0}; pg8::StaticOrder S; S.init(MTOK, 8192, G, bid);
        EpiL1In E{Qb, Kb, VTb, Zb, KPART}; pg8::gemm_phase<EpiL1In, true>(lds, g, S, E);
    }
    SEAM(6);
    if (IN(7)) attn_phase(lds, Qb, Kb, VTb, Zb, KPART, Y1, G, bid);
    SEAM(7);
    if (IN(8)) {
        { pg8::Gemm g{Y1, WOUT1, MTOK, 2048, 2048, 1 << 30, 0}; pg8::StaticOrder S; S.init(MTOK, 2048, G, bid);
          EpiResLn<true> E{SLOTA, X3B, P.ln_g + DM, P.ln_b + DM, ws, 1, 0}; pg8::gemm_phase(lds, g, S, E); }
    }
    SEAM(8);
    if (IN(10)) {
        pg8::Gemm g{X3B, WG1, MTOK, 2048, 2048, 1 << 30, 0}; pg8::StaticOrder S; S.init(MTOK, 2048, G, bid);
        EpiPle<true> E{X3B, PP1, nullptr, P.out}; pg8::gemm_phase<EpiPle<true>, true>(lds, g, S, E);
    }
#undef IN
#undef SEAM
}

extern "C" void kernel_launch(void* const* d_in, const int* in_sizes, int n_in, void* d_out, int out_size, void* d_ws, size_t ws_size, hipStream_t stream) {
    static int grid_blocks = 0;
    if (grid_blocks == 0) {
        if (n_in != 13 || out_size != MTOK * DM || ws_size < WS_END) { fprintf(stderr, "kernel_launch: unexpected shapes (n_in %d out %d ws %zu)\n", n_in, out_size, ws_size); grid_blocks = -1; return; }
        int dev = 0, cus = 0, per_cu = 0;
        hipGetDevice(&dev);
        hipDeviceGetAttribute(&cus, hipDeviceAttributeMultiprocessorCount, dev);
        if (hipFuncSetAttribute((const void*)mk_fwd, hipFuncAttributeMaxDynamicSharedMemorySize, LDS_BYTES) != hipSuccess) { fprintf(stderr, "kernel_launch: hipFuncSetAttribute failed\n"); grid_blocks = -1; return; }
        if (hipOccupancyMaxActiveBlocksPerMultiprocessor(&per_cu, (const void*)mk_fwd, NTHREADS, LDS_BYTES) != hipSuccess || per_cu < 1) { fprintf(stderr, "kernel_launch: occupancy query failed (%d)\n", per_cu); grid_blocks = -1; return; }
        grid_blocks = cus;
    }
    if (grid_blocks < 0) return;
    if (hipMemsetAsync((unsigned char*)d_ws + WS_BAR, 0, 16384 + 32768, stream) != hipSuccess) { fprintf(stderr, "kernel_launch: memset of the barrier words failed\n"); return; }
    Params p{};
    p.x = (const float*)d_in[0]; p.p = (const float*)d_in[1]; p.w_in_a = (const float*)d_in[2]; p.sgu_g = (const float*)d_in[3]; p.sgu_b = (const float*)d_in[4];
    p.w_s = (const float*)d_in[5]; p.b_s = (const float*)d_in[6]; p.w_in_b = (const float*)d_in[7]; p.w_out = (const float*)d_in[8]; p.ln_g = (const float*)d_in[9];
    p.ln_b = (const float*)d_in[10]; p.w_gate = (const float*)d_in[11]; p.w_proj = (const float*)d_in[12];
    p.out = (float*)d_out; p.ws = (unsigned char*)d_ws;
#if ONE_LAUNCH
    p.lo = 0; p.hi = NPHASE;
    void* args[] = {&p};
    hipError_t e = hipLaunchCooperativeKernel((const void*)mk_fwd, dim3(grid_blocks), dim3(NTHREADS), args, LDS_BYTES, stream);
    if (e != hipSuccess) fprintf(stderr, "cooperative launch failed: %s (grid %d)\n", hipGetErrorString(e), grid_blocks);
#else
    for (int k = 0; k < NPHASE; ++k) {
        p.lo = k; p.hi = k + 1;
        hipLaunchKernelGGL(mk_fwd, dim3(grid_blocks), dim3(NTHREADS), LDS_BYTES, stream, p);
    }
#endif
}
```

```cpp
#include <hip/hip_runtime.h>
#include <hip/hip_cooperative_groups.h>
#include <cstdio>
namespace cg = cooperative_groups;

#ifndef ONE_LAUNCH
#define ONE_LAUNCH 1
#endif

#define LAS __attribute__((address_space(3)))
typedef unsigned short bf16_t;
typedef short bf16x8 __attribute__((ext_vector_type(8)));
typedef float f32x4 __attribute__((ext_vector_type(4)));
typedef float f32x2 __attribute__((ext_vector_type(2)));
typedef float f32x16 __attribute__((ext_vector_type(16)));
typedef unsigned u32x4 __attribute__((ext_vector_type(4)));
typedef unsigned u32x2 __attribute__((ext_vector_type(2)));

constexpr int MTOK = 8192, DM = 2048, SEQ = 2048;
constexpr int NTHREADS = 512;
constexpr int LDS_MAIN = 131072, LDS_BYTES = LDS_MAIN + 16;
constexpr size_t TT = 33554432ull;
constexpr size_t WS_WINB = 0, WS_WOUT1 = TT, WS_WG1 = TT + TT / 4, WS_WP = TT + TT / 2, WS_PB = WS_WP + TT / 16, WS_MISC = WS_PB + TT / 4;
constexpr size_t WS_STATS = WS_MISC, WS_KPART = WS_MISC + (2u << 20), WS_WSB = WS_KPART + (512u << 10), WS_BAR = WS_WSB + (512u << 10), WS_CNT = WS_BAR + 16384, WS_SLOTS = WS_CNT + 32768;
constexpr size_t WS_SLOTA = 2 * TT, WS_WINA = 3 * TT, WS_WOUT0 = 3 * TT + 3 * (TT / 4), WS_WG0 = 4 * TT, WS_U = 4 * TT + TT / 4, WS_GV = WS_U + TT, WS_SZ = WS_GV + TT;
constexpr size_t WS_Q = 3 * TT, WS_K = 4 * TT, WS_VT = 5 * TT, WS_Z = 6 * TT, WS_PP1 = 7 * TT, WS_X3B = 4 * TT, WS_PP0 = WS_U, WS_X1B = WS_GV;
constexpr size_t WS_END = 8 * TT;
static_assert(WS_SZ + TT <= WS_END && WS_WSB + (512u << 10) <= WS_SLOTA && WS_GV == WS_U + TT && WS_SZ == WS_U + 2 * TT && WS_K == WS_Q + TT && WS_VT == WS_Q + 2 * TT && WS_Z == WS_Q + 3 * TT, "workspace map");

struct Params {
    const float* x; const float* p; const float* w_in_a; const float* sgu_g; const float* sgu_b; const float* w_s; const float* b_s; const float* w_in_b;
    const float* w_out; const float* ln_g; const float* ln_b; const float* w_gate; const float* w_proj;
    float* out; unsigned char* ws; int lo, hi;
};

__device__ __forceinline__ unsigned cvt_pk_bf16(float lo, float hi) { unsigned r; asm volatile("v_cvt_pk_bf16_f32 %0, %1, %2" : "=v"(r) : "v"(lo), "v"(hi)); return r; }
__device__ __forceinline__ unsigned cvt_pk_bf16_t(float lo, float hi) { unsigned r; asm volatile("s_nop 1\n\tv_cvt_pk_bf16_f32 %0, %1, %2" : "=v"(r) : "v"(lo), "v"(hi)); return r; }
__device__ __forceinline__ float bf_lo(unsigned w) { return __uint_as_float(w << 16); }
__device__ __forceinline__ float bf_hi(unsigned w) { return __uint_as_float(w & 0xffff0000u); }
__device__ __forceinline__ float fast_sigmoid(float v) { return __builtin_amdgcn_rcpf(1.0f + __builtin_amdgcn_exp2f(-1.4426950408889634f * v)); }
__device__ __forceinline__ float silu_f(float v) { return v * fast_sigmoid(v); }
__device__ __forceinline__ float gelu_f(float v) { const float u = 1.5957691216057308f * (v + 0.044715f * v * v * v); return v * fast_sigmoid(u); }

namespace pg8 {
constexpr int BM = 256, BK = 64, HALF = 128, HTB = HALF * BK * 2, STAGE_BYTES = 8 * HTB, NXCD = 8, WGM = 8;
__host__ __device__ __forceinline__ int lds_byte(int r, int c) { const int st = (r >> 4) * 2 + (c >> 5), rr = r & 15, cc = c & 31, ob = rr * 64 + cc * 2; return st * 1024 + (ob ^ (((ob >> 9) & 1) << 5)); }
__host__ __device__ __forceinline__ void stage_rc(int b, int& R, int& C) { const int st = b / 1024, sb = b % 1024, swz = sb ^ (((sb >> 9) & 1) << 5); R = (st >> 1) * 16 + swz / 64; C = (st & 1) * 32 + (swz % 64) / 2; }
__host__ __device__ __forceinline__ int perm32(int rho) { const int n = rho >> 4, i = rho & 15; return 8 * (i >> 2) + 4 * n + (i & 3); }
struct Unit { int pm, pn; };
struct Gemm { const bf16_t* A; const bf16_t* Bt; int M, N, K; int bsplit, badd; };
struct StaticOrder {
    int nM, nN, nwg, G, c;
    __device__ void init(int M, int N, int G_, int c_) { nM = M / BM; nN = N / BM; nwg = nM * nN; G = G_; c = c_; }
    __device__ bool next(int i, Unit& u) const {
        const long L = (long)i * G + c; if (L >= nwg) return false;
        int wgid = (int)L; { const int q = nwg / NXCD, r = nwg % NXCD, xcd = wgid % NXCD, off = wgid / NXCD; wgid = (xcd < r ? xcd * (q + 1) : r * (q + 1) + (xcd - r) * q) + off; }
        const int nig = WGM * nN, gid = wgid / nig, fm = gid * WGM, gsz = (nM - fm) < WGM ? (nM - fm) : WGM;
        u.pm = fm + ((wgid % nig) % gsz); u.pn = (wgid % nig) / gsz; return true;
    }
};
template <class Epi, bool ALIGN_EPI = false, bool SP2 = true>
__device__ __forceinline__ void gemm_phase(LAS unsigned char* lds, const Gemm g, const StaticOrder& S, const Epi& E) {
    const int tid = threadIdx.x, wid = __builtin_amdgcn_readfirstlane(tid >> 6), lane = tid & 63, wr = wid >> 2, wc = wid & 3, fr = lane & 15, fq = lane >> 4;
    const int K = g.K, nt = K / BK;
    unsigned voffA[2], voffB[2];
#pragma unroll
    for (int i = 0; i < 2; ++i) { int R, C; stage_rc(tid * 16 + i * 8192, R, C); const int Rb = (R & ~31) + perm32(R & 31);
        voffA[i] = (unsigned)(R * K + C) * 2u; voffB[i] = (unsigned)(Rb * K + C) * 2u; }
    const size_t kstep = (size_t)(BK * 2);
    const size_t hstep = (size_t)HALF * K * 2;
    const size_t tstep = 2 * hstep;
    const unsigned ldsw = (unsigned)wid * 1024u;
    const int aoff = lds_byte(wr * 64 + fr, fq * 8), boff = lds_byte(wc * 32 + fr, fq * 8);
#define PG8_SA(b, h) (((b) * 2 + (h)) * HTB)
#define PG8_SB(b, h) ((4 + (b) * 2 + (h)) * HTB)
#define PG8_STAGE(bufoff, gbase, voff) do { _Pragma("unroll") for (int _i = 0; _i < 2; ++_i) \
        __builtin_amdgcn_global_load_lds((const unsigned*)((const char*)(gbase) + (voff)[_i]), (LAS unsigned*)(lds + (bufoff) + ldsw + _i * 8192), 16, 0, 0); } while (0)
#define PG8_LDA(dst, b, h) do { _Pragma("unroll") for (int m = 0; m < 4; ++m) _Pragma("unroll") for (int k = 0; k < 2; ++k) dst[m][k] = *(const LAS bf16x8*)(lds + PG8_SA(b, h) + aoff + m * 2048 + k * 1024); } while (0)
#define PG8_LDB(dst, b, h) do { _Pragma("unroll") for (int n = 0; n < 2; ++n) _Pragma("unroll") for (int k = 0; k < 2; ++k) dst[n][k] = *(const LAS bf16x8*)(lds + PG8_SB(b, h) + boff + n * 2048 + k * 1024); } while (0)
#define PG8_MMA(ai, bj, At, Bt) do { __builtin_amdgcn_s_setprio(1); _Pragma("unroll") for (int m = 0; m < 4; ++m) _Pragma("unroll") for (int n = 0; n < 2; ++n) _Pragma("unroll") for (int k = 0; k < 2; ++k) \
        acc[ai][bj][m][n] = __builtin_amdgcn_mfma_f32_16x16x32_bf16(Bt[n][k], At[m][k], acc[ai][bj][m][n], 0, 0, 0); __builtin_amdgcn_s_setprio(0); } while (0)
#define PG8_WAIT_V(n) asm volatile("s_waitcnt vmcnt(" #n ")" ::: "memory")
#define PG8_WAIT_L(n) asm volatile("s_waitcnt lgkmcnt(" #n ")" ::: "memory")
#define PG8_BAR __builtin_amdgcn_s_barrier()
#define PG8_SCHED __builtin_amdgcn_sched_barrier(0)
    Unit cur, nxt; int ui = 0;
    if (!S.next(0, cur)) return;
    f32x4 acc[2][2][4][2];
#pragma unroll
    for (int a = 0; a < 2; ++a)
#pragma unroll
        for (int b = 0; b < 2; ++b)
#pragma unroll
            for (int m = 0; m < 4; ++m)
#pragma unroll
                for (int n = 0; n < 2; ++n) acc[a][b][m][n] = (f32x4){0.f, 0.f, 0.f, 0.f};
    bf16x8 At[4][2], B0[2][2], B1[2][2];
    const char* cA = (const char*)g.A + (size_t)cur.pm * tstep; const char* cB = (const char*)g.Bt + (size_t)(cur.pn + (cur.pm >= g.bsplit ? g.badd : 0)) * tstep;
    if constexpr (SP2) {
        PG8_STAGE(PG8_SB(0, 0), cB, voffB); PG8_STAGE(PG8_SB(0, 1), cB + hstep, voffB); PG8_STAGE(PG8_SA(0, 0), cA, voffA); PG8_STAGE(PG8_SA(0, 1), cA + hstep, voffA);
        if (wr == 1) PG8_BAR;
        PG8_WAIT_V(2); PG8_BAR;
        PG8_STAGE(PG8_SB(1, 0), cB + kstep, voffB); PG8_STAGE(PG8_SA(1, 0), cA + kstep, voffA); PG8_STAGE(PG8_SB(1, 1), cB + hstep + kstep, voffB);
        PG8_WAIT_V(6); PG8_BAR;
    } else {
        PG8_STAGE(PG8_SB(0, 0), cB, voffB); PG8_STAGE(PG8_SA(0, 0), cA, voffA); PG8_STAGE(PG8_SB(0, 1), cB + hstep, voffB); PG8_STAGE(PG8_SA(0, 1), cA + hstep, voffA);
        if (wr == 1) PG8_BAR;
        PG8_WAIT_V(4); PG8_BAR;
        PG8_STAGE(PG8_SB(1, 0), cB + kstep, voffB); PG8_STAGE(PG8_SA(1, 0), cA + kstep, voffA); PG8_STAGE(PG8_SB(1, 1), cB + hstep + kstep, voffB);
        PG8_WAIT_V(6); PG8_BAR;
    }
    for (;;) {
        const bool has_next = S.next(ui + 1, nxt);
        const char* nA = has_next ? (const char*)g.A + (size_t)nxt.pm * tstep : cA; const char* nB = has_next ? (const char*)g.Bt + (size_t)(nxt.pn + (nxt.pm >= g.bsplit ? g.badd : 0)) * tstep : cB;
        for (int t = 0; t < nt; t += 2) {
            const bool last = (t == nt - 2);
            const char* a1 = cA + (size_t)(t + 1) * kstep;
            const char* a2 = last ? nA : cA + (size_t)(t + 2) * kstep; const char* b2 = last ? nB : cB + (size_t)(t + 2) * kstep;
            const char* a3 = a2 + kstep; const char* b3 = b2 + kstep;
            if constexpr (SP2) {
            PG8_LDB(B0, 0, 0); PG8_LDB(B1, 0, 1); PG8_SCHED; PG8_LDA(At, 0, 0); PG8_STAGE(PG8_SA(1, 1), a1 + hstep, voffA);
            PG8_WAIT_V(8); PG8_WAIT_L(0); PG8_BAR; PG8_MMA(0, 0, At, B0); PG8_MMA(0, 1, At, B1); PG8_BAR; PG8_SCHED;
            PG8_LDA(At, 0, 1); PG8_STAGE(PG8_SB(0, 0), b2, voffB); PG8_STAGE(PG8_SB(0, 1), b2 + hstep, voffB); PG8_STAGE(PG8_SA(0, 0), a2, voffA);
            PG8_WAIT_V(8); PG8_WAIT_L(0); PG8_BAR; PG8_MMA(1, 0, At, B0); PG8_MMA(1, 1, At, B1); PG8_BAR; PG8_SCHED;
            PG8_LDB(B0, 1, 0); PG8_LDB(B1, 1, 1); PG8_SCHED; PG8_LDA(At, 1, 0); PG8_STAGE(PG8_SA(0, 1), a2 + hstep, voffA);
            PG8_WAIT_V(8); PG8_WAIT_L(0); PG8_BAR; PG8_MMA(0, 0, At, B0); PG8_MMA(0, 1, At, B1); PG8_BAR; PG8_SCHED;
            PG8_LDA(At, 1, 1); PG8_STAGE(PG8_SB(1, 0), b3, voffB); PG8_STAGE(PG8_SB(1, 1), b3 + hstep, voffB); PG8_STAGE(PG8_SA(1, 0), a3, voffA);
            PG8_WAIT_V(8); PG8_WAIT_L(0); PG8_BAR; PG8_MMA(1, 0, At, B0); PG8_MMA(1, 1, At, B1); PG8_BAR; PG8_SCHED;
            } else {
            PG8_LDB(B0, 0, 0); PG8_SCHED; PG8_LDA(At, 0, 0); PG8_STAGE(PG8_SA(1, 1), a1 + hstep, voffA);
            PG8_WAIT_L(8); PG8_BAR; PG8_WAIT_L(0); PG8_MMA(0, 0, At, B0); PG8_BAR; PG8_SCHED;
            PG8_LDB(B1, 0, 1); PG8_STAGE(PG8_SB(0, 0), b2, voffB);
            PG8_BAR; PG8_WAIT_L(0); PG8_MMA(0, 1, At, B1); PG8_BAR;
            PG8_LDA(At, 0, 1); PG8_STAGE(PG8_SA(0, 0), a2, voffA);
            PG8_BAR; PG8_WAIT_L(0); PG8_MMA(1, 0, At, B0); PG8_BAR; PG8_SCHED;
            PG8_STAGE(PG8_SB(0, 1), b2 + hstep, voffB);
            PG8_WAIT_V(6); PG8_BAR; PG8_MMA(1, 1, At, B1); PG8_BAR;
            PG8_LDB(B0, 1, 0); PG8_SCHED; PG8_LDA(At, 1, 0); PG8_STAGE(PG8_SA(0, 1), a2 + hstep, voffA);
            PG8_WAIT_L(8); PG8_BAR; PG8_WAIT_L(0); PG8_MMA(0, 0, At, B0); PG8_BAR; PG8_SCHED;
            PG8_LDB(B1, 1, 1); PG8_STAGE(PG8_SB(1, 0), b3, voffB);
            PG8_BAR; PG8_WAIT_L(0); PG8_MMA(0, 1, At, B1); PG8_BAR;
            PG8_LDA(At, 1, 1); PG8_STAGE(PG8_SA(1, 0), a3, voffA);
            PG8_BAR; PG8_WAIT_L(0); PG8_MMA(1, 0, At, B0); PG8_BAR; PG8_SCHED;
            PG8_STAGE(PG8_SB(1, 1), b3 + hstep, voffB);
            PG8_WAIT_V(6); PG8_BAR; PG8_MMA(1, 1, At, B1); PG8_BAR;
            }
        }
        if constexpr (ALIGN_EPI) { if (wr == 0) PG8_BAR; }
        if constexpr (!Epi::AFTER_DRAIN) E(acc, cur, wr, wc, fr, fq);
        if (!has_next) break;
#pragma unroll
        for (int a = 0; a < 2; ++a)
#pragma unroll
            for (int b = 0; b < 2; ++b)
#pragma unroll
                for (int m = 0; m < 4; ++m)
#pragma unroll
                    for (int n = 0; n < 2; ++n) acc[a][b][m][n] = (f32x4){0.f, 0.f, 0.f, 0.f};
        cur = nxt; cA = nA; cB = nB; ++ui;
        if constexpr (ALIGN_EPI) { if (wr == 1) PG8_BAR; }
    }
    PG8_WAIT_V(0);
    if constexpr (!ALIGN_EPI) { if (wr == 0) PG8_BAR; }
    PG8_BAR;
    if constexpr (Epi::AFTER_DRAIN) E.fused(acc, cur, wr, wc, fr, fq, lds, wid, lane);
#undef PG8_SA
#undef PG8_SB
#undef PG8_STAGE
#undef PG8_LDA
#undef PG8_LDB
#undef PG8_MMA
#undef PG8_WAIT_V
#undef PG8_WAIT_L
#undef PG8_BAR
#undef PG8_SCHED
}
}
using pg8::Unit;
typedef f32x4 Acc[2][2][4][2];

__device__ __forceinline__ u32x4 pack8(const f32x4 a, const f32x4 b) { u32x4 w; w.x = cvt_pk_bf16(a[0], a[1]); w.y = cvt_pk_bf16(a[2], a[3]); w.z = cvt_pk_bf16(b[0], b[1]); w.w = cvt_pk_bf16(b[2], b[3]); return w; }

struct EpiL0In {
    static constexpr bool AFTER_DRAIN = false;
    bf16_t* UZ; bf16_t* GV; float* stats;
    __device__ __forceinline__ void operator()(const Acc& acc, const Unit& u, int wr, int wc, int fr, int fq) const {
        if (u.pn < 16) {
            const int cb = u.pn * 128 + wc * 32 + 8 * fq;
#pragma unroll
            for (int ai = 0; ai < 2; ++ai)
#pragma unroll
                for (int m = 0; m < 4; ++m) {
                    const int row = u.pm * 256 + ai * 128 + wr * 64 + m * 16 + fr;
                    f32x4 a0 = acc[ai][0][m][0], a1 = acc[ai][0][m][1]; const f32x4 z0 = acc[ai][1][m][0], z1 = acc[ai][1][m][1];
#pragma unroll
                    for (int j = 0; j < 4; ++j) { a0[j] = gelu_f(a0[j]) * silu_f(z0[j]); a1[j] = gelu_f(a1[j]) * silu_f(z1[j]); }
                    *(u32x4*)(UZ + (size_t)row * DM + cb) = pack8(a0, a1);
                }
        } else {
            const int pnv = u.pn - 16, cb = pnv * 256 + wc * 32 + 8 * fq;
#pragma unroll
            for (int ai = 0; ai < 2; ++ai)
#pragma unroll
                for (int m = 0; m < 4; ++m) {
                    const int row = u.pm * 256 + ai * 128 + wr * 64 + m * 16 + fr;
                    float s = 0.f, ss = 0.f;
#pragma unroll
                    for (int bj = 0; bj < 2; ++bj) {
                        f32x4 v0 = acc[ai][bj][m][0], v1 = acc[ai][bj][m][1];
#pragma unroll
                        for (int j = 0; j < 4; ++j) { v0[j] = gelu_f(v0[j]); v1[j] = gelu_f(v1[j]); }
#pragma unroll
                        for (int j = 0; j < 4; ++j) { s += v0[j] + v1[j]; ss += v0[j] * v0[j] + v1[j] * v1[j]; }
                        *(u32x4*)(GV + (size_t)row * DM + cb + bj * 128) = pack8(v0, v1);
                    }
                    s += __shfl_xor(s, 16); s += __shfl_xor(s, 32); ss += __shfl_xor(ss, 16); ss += __shfl_xor(ss, 32);
                    if (fq == 0) *(f32x2*)(stats + ((size_t)row * 32 + pnv * 4 + wc) * 2) = (f32x2){s, ss};
                }
        }
    }
};
struct EpiPlain {
    static constexpr bool AFTER_DRAIN = false;
    bf16_t* O; long long delta2;
    __device__ __forceinline__ void operator()(const Acc& acc, const Unit& u, int wr, int wc, int fr, int fq) const {
        const int cb = u.pn * 256 + wc * 32 + 8 * fq;
        bf16_t* Ob = O + (u.pm >= 32 ? delta2 - (long long)32 * 256 * DM : 0ll);
#pragma unroll
        for (int ai = 0; ai < 2; ++ai)
#pragma unroll
            for (int m = 0; m < 4; ++m) {
                const int row = u.pm * 256 + ai * 128 + wr * 64 + m * 16 + fr;
#pragma unroll
                for (int bj = 0; bj < 2; ++bj) *(u32x4*)(Ob + (size_t)row * DM + cb + bj * 128) = pack8(acc[ai][bj][m][0], acc[ai][bj][m][1]);
            }
    }
};
struct EpiRes {
    static constexpr bool AFTER_DRAIN = false;
    const float* res; float* out; float* stats; float alpha;
    __device__ __forceinline__ void operator()(const Acc& acc, const Unit& u, int wr, int wc, int fr, int fq) const {
        const int cb = u.pn * 256 + wc * 32 + 8 * fq;
#pragma unroll
        for (int ai = 0; ai < 2; ++ai)
#pragma unroll
            for (int m = 0; m < 4; ++m) {
                const int row = u.pm * 256 + ai * 128 + wr * 64 + m * 16 + fr;
                float s = 0.f, ss = 0.f;
#pragma unroll
                for (int bj = 0; bj < 2; ++bj) {
                    const size_t o = (size_t)row * DM + cb + bj * 128;
                    const f32x4 r0 = *(const f32x4*)(res + o), r1 = *(const f32x4*)(res + o + 4);
                    const f32x4 t0 = r0 * alpha + acc[ai][bj][m][0], t1 = r1 * alpha + acc[ai][bj][m][1];
#pragma unroll
                    for (int j = 0; j < 4; ++j) { s += t0[j] + t1[j]; ss += t0[j] * t0[j] + t1[j] * t1[j]; }
                    *(f32x4*)(out + o) = t0; *(f32x4*)(out + o + 4) = t1;
                }
                s += __shfl_xor(s, 16); s += __shfl_xor(s, 32); ss += __shfl_xor(ss, 16); ss += __shfl_xor(ss, 32);
                if (fq == 0) *(f32x2*)(stats + ((size_t)row * 32 + u.pn * 4 + wc) * 2) = (f32x2){s, ss};
            }
    }
};
template <bool RES_BF16> struct EpiResLn {
    static constexpr bool AFTER_DRAIN = true;
    const void* res; bf16_t* xb; const float* g; const float* b; unsigned char* ws; int layer, pad;
    static constexpr float alpha = 1.4142135623730951f;
    __device__ __forceinline__ void operator()(const Acc&, const Unit&, int, int, int, int) const {}
    __device__ __forceinline__ void fused(Acc& acc, const Unit& u, int wr, int wc, int fr, int fq, LAS unsigned char* lds, int wid, int lane) const {
        const int cb = u.pn * 256 + wc * 32 + 8 * fq;
        LAS f32x2* Pt = (LAS f32x2*)lds;
        LAS f32x2* St = (LAS f32x2*)(lds + 8192);
        unsigned long long* slots = (unsigned long long*)(ws + WS_SLOTS) + (size_t)layer * MTOK * 8; unsigned* cnt = (unsigned*)(ws + WS_CNT) + layer * 64 * 32;
#pragma unroll
        for (int ai = 0; ai < 2; ++ai) {
            const size_t ob = (size_t)(u.pm * 256 + ai * 128 + wr * 64 + fr) * DM + cb;
            f32x4 rr[4][2][2];
#pragma unroll
            for (int m = 0; m < 4; ++m)
#pragma unroll
                for (int bj = 0; bj < 2; ++bj) {
                    const size_t o = ob + (size_t)m * 16 * DM + bj * 128;
                    if constexpr (RES_BF16) { const u32x4 rw = *(const u32x4*)((const bf16_t*)res + o);
                        rr[m][bj][0] = (f32x4){bf_lo(rw.x), bf_hi(rw.x), bf_lo(rw.y), bf_hi(rw.y)}; rr[m][bj][1] = (f32x4){bf_lo(rw.z), bf_hi(rw.z), bf_lo(rw.w), bf_hi(rw.w)}; }
                    else { rr[m][bj][0] = *(const f32x4*)((const float*)res + o); rr[m][bj][1] = *(const f32x4*)((const float*)res + o + 4); }
                }
#pragma unroll
            for (int m = 0; m < 4; ++m) {
                const int rl = ai * 128 + wr * 64 + m * 16 + fr;
                float s = 0.f, ss = 0.f;
#pragma unroll
                for (int bj = 0; bj < 2; ++bj) {
                    const f32x4 t0 = rr[m][bj][0] * alpha + acc[ai][bj][m][0], t1 = rr[m][bj][1] * alpha + acc[ai][bj][m][1];
                    acc[ai][bj][m][0] = t0; acc[ai][bj][m][1] = t1;
#pragma unroll
                    for (int j = 0; j < 4; ++j) { s += t0[j] + t1[j]; ss += t0[j] * t0[j] + t1[j] * t1[j]; }
                }
                s += __shfl_xor(s, 16); s += __shfl_xor(s, 32); ss += __shfl_xor(ss, 16); ss += __shfl_xor(ss, 32);
                if (fq == 0) Pt[rl * 4 + wc] = (f32x2){s, ss};
            }
        }
        asm volatile("s_waitcnt lgkmcnt(0)" ::: "memory"); __builtin_amdgcn_s_barrier(); asm volatile("" ::: "memory");
        const int rowi = wid * 32 + (lane & 31);
        if (lane < 32) {
            const f32x2 a = Pt[rowi * 4 + 0], b2 = Pt[rowi * 4 + 1], c = Pt[rowi * 4 + 2], d = Pt[rowi * 4 + 3];
            const float S = (a.x + b2.x) + (c.x + d.x), SS = (a.y + b2.y) + (c.y + d.y);
            unsigned long long* slot = slots + ((size_t)(u.pm * 256 + rowi) * 8 + u.pn);
            __hip_atomic_store(slot, ((unsigned long long)__float_as_uint(SS) << 32) | __float_as_uint(S), __ATOMIC_RELAXED, __HIP_MEMORY_SCOPE_AGENT);
        }
        asm volatile("s_waitcnt vmcnt(0)" ::: "memory");
        if (lane == 0) __hip_atomic_fetch_add(cnt + 64 * u.pm, 1u, __ATOMIC_RELAXED, __HIP_MEMORY_SCOPE_AGENT);
        if (wid == 0) {
            unsigned sp = 0u;
            while ((unsigned)__builtin_amdgcn_readfirstlane(__hip_atomic_load(cnt + 64 * u.pm, __ATOMIC_RELAXED, __HIP_MEMORY_SCOPE_AGENT)) < 64u) { __builtin_amdgcn_s_sleep(2); if (++sp > (1u << 22)) break; }
            __builtin_amdgcn_fence(__ATOMIC_ACQUIRE, "agent");
        }
        asm volatile("s_waitcnt vmcnt(0) lgkmcnt(0)" ::: "memory"); __builtin_amdgcn_s_barrier(); asm volatile("" ::: "memory");
        if (lane < 32) {
            const unsigned long long* slot = slots + (size_t)(u.pm * 256 + rowi) * 8; float S = 0.f, SS = 0.f;
#pragma unroll
            for (int t = 0; t < 8; ++t) { const unsigned long long w = __hip_atomic_load(slot + t, __ATOMIC_RELAXED, __HIP_MEMORY_SCOPE_AGENT); S += __uint_as_float((unsigned)w); SS += __uint_as_float((unsigned)(w >> 32)); }
            const float mean = S * (1.0f / DM), var = SS * (1.0f / DM) - mean * mean;
            St[rowi] = (f32x2){mean, rsqrtf(var + 1e-5f)};
        }
        asm volatile("s_waitcnt lgkmcnt(0)" ::: "memory"); __builtin_amdgcn_s_barrier(); asm volatile("" ::: "memory");
#pragma unroll
        for (int bj = 0; bj < 2; ++bj) {
            const f32x4 g0 = *(const f32x4*)(g + cb + bj * 128), g1 = *(const f32x4*)(g + cb + bj * 128 + 4), b0 = *(const f32x4*)(b + cb + bj * 128), b1 = *(const f32x4*)(b + cb + bj * 128 + 4);
#pragma unroll
            for (int ai = 0; ai < 2; ++ai)
#pragma unroll
                for (int m = 0; m < 4; ++m) {
                    const int rl = ai * 128 + wr * 64 + m * 16 + fr;
                    const f32x2 st = St[rl];
                    const size_t o = (size_t)(u.pm * 256 + rl) * DM + cb + bj * 128;
                    const f32x4 o0 = (acc[ai][bj][m][0] - st.x) * st.y * g0 + b0, o1 = (acc[ai][bj][m][1] - st.x) * st.y * g1 + b1;
                    *(u32x4*)(xb + o) = pack8(o0, o1);
                }
        }
    }
};
template <bool OUT_F32> struct EpiPle {
    static constexpr bool AFTER_DRAIN = false;
    const bf16_t* xin; const bf16_t* pp; bf16_t* xb; float* outf;
    __device__ __forceinline__ void operator()(const Acc& acc, const Unit& u, int wr, int wc, int fr, int fq) const {
        const int cb = u.pn * 256 + wc * 32 + 8 * fq;
#pragma unroll
        for (int ai = 0; ai < 2; ++ai) {
            const size_t o0 = (size_t)(u.pm * 256 + ai * 128 + wr * 64 + fr) * DM + cb;
            u32x4 xw[4][2], pw[4][2];
#pragma unroll
            for (int m = 0; m < 4; ++m)
#pragma unroll
                for (int bj = 0; bj < 2; ++bj) { const size_t o = o0 + (size_t)m * 16 * DM + bj * 128; xw[m][bj] = *(const u32x4*)(xin + o); pw[m][bj] = *(const u32x4*)(pp + o); }
#pragma unroll
            for (int m = 0; m < 4; ++m)
#pragma unroll
                for (int bj = 0; bj < 2; ++bj) {
                    const size_t o = o0 + (size_t)m * 16 * DM + bj * 128;
                    const u32x4 x = xw[m][bj], p = pw[m][bj];
                    const f32x4 a0 = acc[ai][bj][m][0], a1 = acc[ai][bj][m][1];
                    f32x4 r0, r1;
                    r0[0] = bf_lo(x.x) + fast_sigmoid(a0[0]) * bf_lo(p.x); r0[1] = bf_hi(x.x) + fast_sigmoid(a0[1]) * bf_hi(p.x);
                    r0[2] = bf_lo(x.y) + fast_sigmoid(a0[2]) * bf_lo(p.y); r0[3] = bf_hi(x.y) + fast_sigmoid(a0[3]) * bf_hi(p.y);
                    r1[0] = bf_lo(x.z) + fast_sigmoid(a1[0]) * bf_lo(p.z); r1[1] = bf_hi(x.z) + fast_sigmoid(a1[1]) * bf_hi(p.z);
                    r1[2] = bf_lo(x.w) + fast_sigmoid(a1[2]) * bf_lo(p.w); r1[3] = bf_hi(x.w) + fast_sigmoid(a1[3]) * bf_hi(p.w);
                    if constexpr (OUT_F32) { *(f32x4*)(outf + o) = r0; *(f32x4*)(outf + o + 4) = r1; }
                    else *(u32x4*)(xb + o) = pack8(r0, r1);
                }
        }
    }
};
struct EpiL1In {
    static constexpr bool AFTER_DRAIN = false;
    bf16_t* Q; bf16_t* Kb; bf16_t* VT; bf16_t* Z; float* kpart;
    __device__ __forceinline__ void operator()(const Acc& acc, const Unit& u, int wr, int wc, int fr, int fq) const {
        const int type = u.pn >> 3, cb = (u.pn & 7) * 256 + wc * 32 + 8 * fq;
        if (type == 2) {
            const int b = u.pm >> 3, sb = (u.pm & 7) * 256 + wr * 64;
            const int pos = (fr < 4 || fr >= 12) ? fr : (fr < 8 ? fr + 4 : fr - 4);
#pragma unroll
            for (int bj = 0; bj < 2; ++bj)
#pragma unroll
                for (int n = 0; n < 2; ++n)
#pragma unroll
                    for (int j = 0; j < 4; ++j) {
                        const int c = cb + bj * 128 + 4 * n + j, h = c >> 7, d = c & 127;
                        bf16_t* base = VT + ((size_t)((b * 16 + h) * 128 + d)) * SEQ + sb + pos;
#pragma unroll
                        for (int ai = 0; ai < 2; ++ai)
#pragma unroll
                            for (int m = 0; m < 4; ++m) base[ai * 128 + m * 16] = (bf16_t)(cvt_pk_bf16(acc[ai][bj][m][n][j], 0.f) & 0xffffu);
                    }
            return;
        }
        bf16_t* O = Q + (size_t)type * (TT / 2);
        const float qs = 0.08838834764831845f * 1.4426950408889634f;
#pragma unroll
        for (int ai = 0; ai < 2; ++ai)
#pragma unroll
            for (int m = 0; m < 4; ++m) {
                const int row = u.pm * 256 + ai * 128 + wr * 64 + m * 16 + fr;
#pragma unroll
                for (int bj = 0; bj < 2; ++bj) {
                    f32x4 v0 = acc[ai][bj][m][0], v1 = acc[ai][bj][m][1];
                    if (type == 0) { v0 *= qs; v1 *= qs; }
                    if (type == 3) {
#pragma unroll
                        for (int j = 0; j < 4; ++j) { v0[j] = silu_f(v0[j]); v1[j] = silu_f(v1[j]); }
                    }
                    *(u32x4*)(O + (size_t)row * DM + cb + bj * 128) = pack8(v0, v1);
                }
            }
        if (type == 1) {
            float* kp = kpart + ((size_t)(u.pm * 2 + wr)) * DM;
#pragma unroll
            for (int bj = 0; bj < 2; ++bj)
#pragma unroll
                for (int n = 0; n < 2; ++n) {
                    f32x4 cs = (f32x4){0.f, 0.f, 0.f, 0.f};
#pragma unroll
                    for (int ai = 0; ai < 2; ++ai)
#pragma unroll
                        for (int m = 0; m < 4; ++m) cs += acc[ai][bj][m][n];
#pragma unroll
                    for (int j = 0; j < 4; ++j) { float v = cs[j]; v += __shfl_xor(v, 1); v += __shfl_xor(v, 2); v += __shfl_xor(v, 4); v += __shfl_xor(v, 8); cs[j] = v; }
                    if (fr == 0) *(f32x4*)(kp + cb + bj * 128 + 4 * n) = cs;
                }
        }
    }
};

template <bool REMAP = false>
__device__ __forceinline__ void transpose_convert(LAS unsigned char* lds, const float* src, bf16_t* dst, int K, int N, int G, int bid) {
    LAS float* tile = (LAS float*)lds;
    const int tid = threadIdx.x, ntn = N / 64, ntiles = (K / 128) * ntn;
    const int r0 = tid >> 4, c4 = tid & 15;
    f32x4 v[4];
    if (bid < ntiles) { const int k0 = (bid / ntn) * 128, n0 = (bid % ntn) * 64;
#pragma unroll
        for (int i = 0; i < 4; ++i) v[i] = __builtin_nontemporal_load((const f32x4*)(src + (size_t)(k0 + r0 + 32 * i) * N + n0 + c4 * 4)); }
    for (int t = bid; t < ntiles; t += G) {
        const int k0 = (t / ntn) * 128, n0 = (t % ntn) * 64;
        asm volatile("s_waitcnt lgkmcnt(0)" ::: "memory"); __builtin_amdgcn_s_barrier(); asm volatile("" ::: "memory");
#pragma unroll
        for (int i = 0; i < 4; ++i) {
#pragma unroll
            for (int j = 0; j < 4; ++j) tile[(r0 + 32 * i) * 65 + c4 * 4 + j] = v[i][j]; }
        asm volatile("s_waitcnt lgkmcnt(0)" ::: "memory"); __builtin_amdgcn_s_barrier(); asm volatile("" ::: "memory");
        if (t + G < ntiles) { const int k1 = ((t + G) / ntn) * 128, n1 = ((t + G) % ntn) * 64;
#pragma unroll
            for (int i = 0; i < 4; ++i) v[i] = __builtin_nontemporal_load((const f32x4*)(src + (size_t)(k1 + r0 + 32 * i) * N + n1 + c4 * 4)); }
#pragma unroll
        for (int i = 0; i < 2; ++i) { const int id = tid + 512 * i, n = id >> 4, kc = id & 15;
            float f[8];
#pragma unroll
            for (int j = 0; j < 8; ++j) f[j] = tile[(kc * 8 + j) * 65 + n];
            u32x4 w; w.x = cvt_pk_bf16(f[0], f[1]); w.y = cvt_pk_bf16(f[2], f[3]); w.z = cvt_pk_bf16(f[4], f[5]); w.w = cvt_pk_bf16(f[6], f[7]);
            const int nd = !REMAP ? n0 : (n0 < 2048 ? (n0 >> 7) * 256 + (n0 & 127) : (n0 < 4096 ? n0 + 2048 : ((n0 - 4096) >> 7) * 256 + 128 + (n0 & 127)));
            *(u32x4*)(dst + (size_t)(nd + n) * K + k0 + kc * 8) = w; }
    }
    __syncthreads();
}
__device__ __forceinline__ void convert_flat(const float* src, bf16_t* dst, size_t n, int G, int bid) {
    const size_t n8 = n / 8, stride = (size_t)G * NTHREADS;
    size_t i = (size_t)bid * NTHREADS + threadIdx.x;
    for (; i + 3 * stride < n8; i += 4 * stride) {
        f32x4 a[4], b[4];
#pragma unroll
        for (int u = 0; u < 4; ++u) { a[u] = __builtin_nontemporal_load((const f32x4*)(src + (i + u * stride) * 8)); b[u] = __builtin_nontemporal_load((const f32x4*)(src + (i + u * stride) * 8 + 4)); }
#pragma unroll
        for (int u = 0; u < 4; ++u) *(u32x4*)(dst + (i + u * stride) * 8) = pack8(a[u], b[u]);
    }
    for (; i < n8; i += stride) {
        const f32x4 a = __builtin_nontemporal_load((const f32x4*)(src + i * 8)), b = __builtin_nontemporal_load((const f32x4*)(src + i * 8 + 4));
        *(u32x4*)(dst + i * 8) = pack8(a, b);
    }
}

__device__ __forceinline__ void ln_apply_phase(float* xf, const float* stats, const float* g, const float* bta, bf16_t* xb, int G, int bid) {
    const int wid = threadIdx.x >> 6, lane = threadIdx.x & 63;
    for (int row = bid * 8 + wid; row < MTOK; row += G * 8) {
        float s = 0.f, ss = 0.f;
        if (lane < 32) { const f32x2 pr = *(const f32x2*)(stats + ((size_t)row * 32 + lane) * 2); s = pr.x; ss = pr.y; }
#pragma unroll
        for (int o = 32; o >= 1; o >>= 1) { s += __shfl_xor(s, o); ss += __shfl_xor(ss, o); }
        const float mean = s * (1.0f / DM), var = ss * (1.0f / DM) - mean * mean, rstd = rsqrtf(var + 1e-5f);
        float* xr = xf + (size_t)row * DM;
#pragma unroll
        for (int i = 0; i < 4; ++i) {
            const int c = i * 512 + lane * 8;
            const f32x4 t0 = *(const f32x4*)(xr + c), t1 = *(const f32x4*)(xr + c + 4);
            const f32x4 g0 = *(const f32x4*)(g + c), g1 = *(const f32x4*)(g + c + 4), b0 = *(const f32x4*)(bta + c), b1 = *(const f32x4*)(bta + c + 4);
            const f32x4 o0 = (t0 - mean) * rstd * g0 + b0, o1 = (t1 - mean) * rstd * g1 + b1;
            *(f32x4*)(xr + c) = o0; *(f32x4*)(xr + c + 4) = o1;
            *(u32x4*)(xb + (size_t)row * DM + c) = pack8(o0, o1);
        }
    }
}

__device__ __forceinline__ void sgu_phase(LAS unsigned char* lds, const bf16_t* U, const bf16_t* GV, const bf16_t* SZ, const float* stats, const float* vg, const float* vb,
                                          const bf16_t* wsb, const float* b_s, bf16_t* Y, int G, int bid) {
    constexpr int VST = 272;
    LAS unsigned char* vnT = lds;
    LAS f32x2* rstat = (LAS f32x2*)(lds + 128 * VST);
    const int tid = threadIdx.x, wid = tid >> 6, lane = tid & 63, fr = lane & 15, fq = lane >> 4;
    for (int it = bid; it < 1024; it += G) {
        const int ci = it >> 4, g = it & 15, row0 = ci * 128;
        __syncthreads();
        if (tid < 128) {
            const float* sp = stats + (size_t)(row0 + tid) * 64; float s = 0.f, ss = 0.f;
#pragma unroll
            for (int i = 0; i < 16; ++i) { const f32x4 q = *(const f32x4*)(sp + i * 4); s += q[0] + q[2]; ss += q[1] + q[3]; }
            const float mean = s * (1.0f / DM), var = ss * (1.0f / DM) - mean * mean;
            rstat[tid] = (f32x2){mean, rsqrtf(var + 1e-5f)};
        }
        __syncthreads();
#pragma unroll
        for (int i = 0; i < 4; ++i) {
            const int id = tid + 512 * i, r = id >> 4, cc = id & 15;
            const u32x4 w = *(const u32x4*)(GV + (size_t)(row0 + r) * DM + g * 128 + cc * 8);
            const f32x2 st = rstat[r];
            const f32x4 g0 = *(const f32x4*)(vg + g * 128 + cc * 8), g1 = *(const f32x4*)(vg + g * 128 + cc * 8 + 4);
            const f32x4 b0 = *(const f32x4*)(vb + g * 128 + cc * 8), b1 = *(const f32x4*)(vb + g * 128 + cc * 8 + 4);
            float f[8] = {bf_lo(w.x), bf_hi(w.x), bf_lo(w.y), bf_hi(w.y), bf_lo(w.z), bf_hi(w.z), bf_lo(w.w), bf_hi(w.w)};
#pragma unroll
            for (int j = 0; j < 8; ++j) {
                const float gg = j < 4 ? g0[j & 3] : g1[j & 3], bb = j < 4 ? b0[j & 3] : b1[j & 3];
                const float vn = (f[j] - st.x) * st.y * gg + bb;
                *(LAS bf16_t*)(vnT + (cc * 8 + j) * VST + (((r >> 3) ^ cc) << 4) + (r & 7) * 2) = (bf16_t)(cvt_pk_bf16(vn, 0.f) & 0xffffu);
            }
        }
        __syncthreads();
        f32x4 acc[8];
#pragma unroll
        for (int ct = 0; ct < 8; ++ct) acc[ct] = (f32x4){0.f, 0.f, 0.f, 0.f};
        const bf16_t* wrow = wsb + ((size_t)g * 128 + wid * 16 + fr) * 128 + fq * 8;
        const int nks = (wid >> 1) + 1;
        for (int ks = 0; ks < nks; ++ks) {
            const bf16x8 wf = *(const bf16x8*)(wrow + ks * 32);
#pragma unroll
            for (int ct = 0; ct < 8; ++ct) {
                const bf16x8 vf = *(const LAS bf16x8*)(vnT + (ct * 16 + fr) * VST + (((ks * 4 + fq) ^ (ct * 2 + (fr >> 3))) << 4));
                acc[ct] = __builtin_amdgcn_mfma_f32_16x16x32_bf16(vf, wf, acc[ct], 0, 0, 0);
            }
        }
        const int t = wid * 16 + fr; const float bs = b_s[g * 128 + t];
        const size_t ro = (size_t)(row0 + t) * DM + g * 128 + 4 * fq;
#pragma unroll
        for (int ct = 0; ct < 8; ++ct) {
            const u32x2 uw = *(const u32x2*)(U + ro + ct * 16);
            const float y0 = bf_lo(uw.x) * (acc[ct][0] + bs), y1 = bf_hi(uw.x) * (acc[ct][1] + bs);
            const float y2 = bf_lo(uw.y) * (acc[ct][2] + bs), y3 = bf_hi(uw.y) * (acc[ct][3] + bs);
            u32x2 o; o.x = cvt_pk_bf16(y0, y1); o.y = cvt_pk_bf16(y2, y3);
            *(u32x2*)(Y + ro + ct * 16) = o;
        }
    }
    __syncthreads();
}

#define MFMA32(a, b, c) __builtin_amdgcn_mfma_f32_32x32x16_bf16((a), (b), (c), 0, 0, 0)
__device__ __forceinline__ void attn_phase(LAS unsigned char* lds, const bf16_t* Q, const bf16_t* Kb, const bf16_t* VT, const bf16_t* Z, const float* kpart, bf16_t* Y, int G, int bid) {
    constexpr int KST = 272, VSTR = 144, KBUF = 64 * KST, VBUF = 128 * VSTR;
    const int tid = threadIdx.x, wid = __builtin_amdgcn_readfirstlane(tid >> 6), lane = tid & 63, qr = lane & 31, hh = lane >> 5;
    const float NEG = -__builtin_inff();
    for (int pair = bid; pair < 256; pair += G) {
        const int bh = pair >> 2, jp = pair & 3, b = bh >> 4, h = bh & 15;
        for (int half = 0; half < 2; ++half) {
            const int own = half == 0 ? 7 - jp : jp;
            const int q0 = own * 256 + wid * 32;
            const size_t qoff = (size_t)(b * SEQ + q0 + qr) * DM + h * 128;
            bf16x8 Qf[8];
#pragma unroll
            for (int ks = 0; ks < 8; ++ks) Qf[ks] = *(const bf16x8*)(Q + qoff + ks * 16 + hh * 8);
            unsigned selmask = (1u << own) - 1u;
            if (own > 3) {
                f32x16 gacc;
#pragma unroll
                for (int j = 0; j < 16; ++j) gacc[j] = 0.f;
#pragma unroll
                for (int ks = 0; ks < 8; ++ks) {
                    u32x4 w = (u32x4){0u, 0u, 0u, 0u};
                    if (qr < 8) {
                        const float* kp = kpart + ((size_t)((b * 8 + qr) * 2)) * DM + h * 128 + ks * 16 + hh * 8;
                        const f32x4 a0 = *(const f32x4*)(kp), a1 = *(const f32x4*)(kp + 4), c0 = *(const f32x4*)(kp + DM), c1 = *(const f32x4*)(kp + DM + 4);
                        w = pack8((a0 + c0) * (1.0f / 256.0f), (a1 + c1) * (1.0f / 256.0f));
                    }
                    bf16x8 af; __builtin_memcpy(&af, &w, 16);
                    gacc = MFMA32(af, Qf[ks], gacc);
                }
                float gt[8];
#pragma unroll
                for (int j = 0; j < 4; ++j) { const float mine = gacc[j], oth = __shfl_xor(mine, 32); gt[j] = hh == 0 ? mine : oth; gt[4 + j] = hh == 0 ? oth : mine; }
#pragma unroll
                for (int j = 0; j < 8; ++j) if (j >= own) gt[j] = NEG;
                selmask = 0u;
#pragma unroll
                for (int r = 0; r < 3; ++r) {
                    float best = NEG; unsigned bi = 0u;
#pragma unroll
                    for (int j = 0; j < 8; ++j) { const bool take = !((selmask >> j) & 1u) && gt[j] > best; best = take ? gt[j] : best; bi = take ? (unsigned)j : bi; }
                    selmask |= 1u << bi;
                }
            }
            f32x16 O[4];
#pragma unroll
            for (int dt = 0; dt < 4; ++dt)
#pragma unroll
                for (int j = 0; j < 16; ++j) O[dt][j] = 0.f;
            float mrow = NEG, lsum = 0.f;
            const int ntile = (own + 1) * 4;
            const bf16_t* kg = Kb + (size_t)(b * SEQ) * DM + h * 128;
            const bf16_t* vg = VT + (size_t)((b * 16 + h) * 128) * SEQ;
            u32x4 kreg[2], vreg[2];
#define ATT_LOAD(i_) do { const int _i = (i_); const int _kt = _i < 4 ? own * 4 + _i : _i - 4; \
                _Pragma("unroll") for (int c2 = 0; c2 < 2; ++c2) { const int id = tid + 512 * c2; \
                    kreg[c2] = *(const u32x4*)(kg + (size_t)(_kt * 64 + (id >> 4)) * DM + (id & 15) * 8); \
                    vreg[c2] = *(const u32x4*)(vg + (size_t)(id >> 3) * SEQ + _kt * 64 + (id & 7) * 8); } } while (0)
#define ATT_STORE(buf_) do { _Pragma("unroll") for (int c2 = 0; c2 < 2; ++c2) { const int id = tid + 512 * c2; \
                    *(LAS u32x4*)(lds + (buf_) * KBUF + (id >> 4) * KST + (id & 15) * 16) = kreg[c2]; \
                    *(LAS u32x4*)(lds + 2 * KBUF + (buf_) * VBUF + (id >> 3) * VSTR + (id & 7) * 16) = vreg[c2]; } } while (0)
            ATT_LOAD(0);
            __syncthreads();
            ATT_STORE(0);
            ATT_LOAD(1);
            __syncthreads();
            for (int i = 0; i < ntile; ++i) {
                const int kt = i < 4 ? own * 4 + i : i - 4, buf = i & 1;
                const bool is_own = i < 4;
                const bool skip = is_own && (kt * 64 > q0 + 31);
                if (!skip) {
                    const LAS unsigned char* kb_ = lds + buf * KBUF;
                    const LAS unsigned char* vb_ = lds + 2 * KBUF + buf * VBUF;
                    f32x16 s0, s1;
                    const float sinit = (i == 0) ? 0.f : ((is_own || ((selmask >> (kt >> 2)) & 1u)) ? -mrow : -1.0e30f);
#pragma unroll
                    for (int j = 0; j < 16; ++j) { s0[j] = sinit; s1[j] = sinit; }
                    {
                        const LAS unsigned char* kp0 = kb_ + qr * KST + hh * 16; const LAS unsigned char* kp1 = kp0 + 32 * KST;
                        bf16x8 k0a = *(const LAS bf16x8*)(kp0), k0c = *(const LAS bf16x8*)(kp1);
                        bf16x8 k1a = *(const LAS bf16x8*)(kp0 + 32), k1c = *(const LAS bf16x8*)(kp1 + 32);
                        bf16x8 k2a = *(const LAS bf16x8*)(kp0 + 64), k2c = *(const LAS bf16x8*)(kp1 + 64);
#pragma unroll
                        for (int ks = 0; ks < 8; ++ks) {
                            bf16x8 na = k2a, nc = k2c;
                            if (ks < 5) { na = *(const LAS bf16x8*)(kp0 + (ks + 3) * 32); nc = *(const LAS bf16x8*)(kp1 + (ks + 3) * 32); }
                            __builtin_amdgcn_sched_barrier(0);
                            s0 = MFMA32(k0a, Qf[ks], s0); s1 = MFMA32(k0c, Qf[ks], s1);
                            __builtin_amdgcn_sched_barrier(0);
                            k0a = k1a; k0c = k1c; k1a = k2a; k1c = k2c; k2a = na; k2c = nc;
                        }
                    }
                    if (is_own) {
                        if (kt * 64 + 63 > q0) {
                            const int qpos = q0 + qr, kb0 = kt * 64 + hh * 4;
#pragma unroll
                            for (int j = 0; j < 16; ++j) { const int key = kb0 + (j >> 2) * 8 + (j & 3); if (key > qpos) s0[j] = NEG; if (key + 32 > qpos) s1[j] = NEG; }
                        }
                    }
                    if (i == 0) {
                        float mx = s0[0];
#pragma unroll
                        for (int j = 1; j < 16; ++j) mx = fmaxf(mx, s0[j]);
#pragma unroll
                        for (int j = 0; j < 16; ++j) mx = fmaxf(mx, s1[j]);
                        mx = fmaxf(mx, __shfl_xor(mx, 32));
                        mrow = mx;
#pragma unroll
                        for (int j = 0; j < 16; ++j) { s0[j] -= mx; s1[j] -= mx; }
                    }
                    float ps = 0.f;
#pragma unroll
                    for (int j = 0; j < 16; ++j) { s0[j] = __builtin_amdgcn_exp2f(s0[j]); s1[j] = __builtin_amdgcn_exp2f(s1[j]); ps += s0[j] + s1[j]; }
                    lsum += ps;
                    bf16x8 P[4];
                    { u32x4 w;
                      w.x = cvt_pk_bf16_t(s0[0], s0[1]); w.y = cvt_pk_bf16_t(s0[2], s0[3]); w.z = cvt_pk_bf16_t(s0[4], s0[5]); w.w = cvt_pk_bf16_t(s0[6], s0[7]); __builtin_memcpy(&P[0], &w, 16);
                      w.x = cvt_pk_bf16_t(s0[8], s0[9]); w.y = cvt_pk_bf16_t(s0[10], s0[11]); w.z = cvt_pk_bf16_t(s0[12], s0[13]); w.w = cvt_pk_bf16_t(s0[14], s0[15]); __builtin_memcpy(&P[1], &w, 16);
                      w.x = cvt_pk_bf16_t(s1[0], s1[1]); w.y = cvt_pk_bf16_t(s1[2], s1[3]); w.z = cvt_pk_bf16_t(s1[4], s1[5]); w.w = cvt_pk_bf16_t(s1[6], s1[7]); __builtin_memcpy(&P[2], &w, 16);
                      w.x = cvt_pk_bf16_t(s1[8], s1[9]); w.y = cvt_pk_bf16_t(s1[10], s1[11]); w.z = cvt_pk_bf16_t(s1[12], s1[13]); w.w = cvt_pk_bf16_t(s1[14], s1[15]); __builtin_memcpy(&P[3], &w, 16); }
                    {
                        const LAS unsigned char* vp = vb_ + qr * VSTR + hh * 16;
#define ATT_VADDR(st_, half_) (vp + (((st_) >> 2)) * 32 * VSTR + (((st_) & 3) + (half_)) * 32)
                        bf16x8 v0a = *(const LAS bf16x8*)ATT_VADDR(0, 0), v0c = *(const LAS bf16x8*)ATT_VADDR(0, 1);
                        bf16x8 v1a = *(const LAS bf16x8*)ATT_VADDR(2, 0), v1c = *(const LAS bf16x8*)ATT_VADDR(2, 1);
                        bf16x8 v2a = *(const LAS bf16x8*)ATT_VADDR(4, 0), v2c = *(const LAS bf16x8*)ATT_VADDR(4, 1);
#pragma unroll
                        for (int st = 0; st < 16; st += 2) {
                            const int dt = st >> 2, kk = st & 3;
                            bf16x8 na = v2a, nc = v2c;
                            if (st < 10) { na = *(const LAS bf16x8*)ATT_VADDR(st + 6, 0); nc = *(const LAS bf16x8*)ATT_VADDR(st + 6, 1); }
                            __builtin_amdgcn_sched_barrier(0);
                            O[dt] = MFMA32(v0a, P[kk], O[dt]); O[dt] = MFMA32(v0c, P[kk + 1], O[dt]);
                            __builtin_amdgcn_sched_barrier(0);
                            v0a = v1a; v0c = v1c; v1a = v2a; v1c = v2c; v2a = na; v2c = nc;
                        }
#undef ATT_VADDR
                    }
                }
                if (i + 1 < ntile) ATT_STORE((i + 1) & 1);
                asm volatile("s_waitcnt lgkmcnt(0)" ::: "memory"); __builtin_amdgcn_s_barrier(); asm volatile("" ::: "memory");
                if (i + 2 < ntile) ATT_LOAD(i + 2);
            }
#undef ATT_LOAD
#undef ATT_STORE
            const float ltot = lsum + __shfl_xor(lsum, 32), inv = 1.0f / ltot;
#pragma unroll
            for (int dt = 0; dt < 4; ++dt)
#pragma unroll
                for (int i4 = 0; i4 < 4; ++i4) {
                    const size_t o = qoff + dt * 32 + i4 * 8 + hh * 4;
                    const u32x2 zw = *(const u32x2*)(Z + o);
                    u32x2 ow;
                    ow.x = cvt_pk_bf16(O[dt][4 * i4 + 0] * inv * bf_lo(zw.x), O[dt][4 * i4 + 1] * inv * bf_hi(zw.x));
                    ow.y = cvt_pk_bf16(O[dt][4 * i4 + 2] * inv * bf_lo(zw.y), O[dt][4 * i4 + 3] * inv * bf_hi(zw.y));
                    *(u32x2*)(Y + o) = ow;
                }
        }
    }
    __syncthreads();
}


#define XB_TMO      128
#define XB_XCNT(j)  (256  + 64 * (j))
#define XB_XSUB(j)  (1280 + 64 * (j))
#define XB_XGEN(j)  (2304 + 64 * (j))
#define XB_TOP      3328
#define XB_TOPGEN   3392
#define XCD_BAR_WORDS 3456
#define XB_SPIN_CAP (1u << 18)
__device__ __forceinline__ unsigned xb_ld(unsigned* p)              { return __hip_atomic_load(p, __ATOMIC_RELAXED, __HIP_MEMORY_SCOPE_AGENT); }
__device__ __forceinline__ unsigned xb_add(unsigned* p, unsigned v) { return __hip_atomic_fetch_add(p, v, __ATOMIC_RELAXED, __HIP_MEMORY_SCOPE_AGENT); }
__device__ __forceinline__ unsigned xb_xcc_id() { return (unsigned)__builtin_amdgcn_s_getreg((3 << 11) | 20) & 0xFu; }
#define XB_SPIN(cond, bar) do { unsigned _sp = 0; while (cond) { __builtin_amdgcn_s_sleep(1); \
    if ((++_sp & 255u) == 0u) { if (xb_ld(&(bar)[XB_TMO])) break; if (_sp > XB_SPIN_CAP) { atomicAdd(&(bar)[XB_TMO], 1u); break; } } } } while (0)
struct XcdBarrier { unsigned* bar; unsigned x; volatile LAS unsigned* st; };
__device__ __forceinline__ XcdBarrier xcd_barrier_post(unsigned* bar, volatile LAS unsigned* st) {
    XcdBarrier b; b.bar = bar; b.x = xb_xcc_id(); b.st = st;
    if (threadIdx.x == 0) (void)xb_add(&bar[XB_XCNT(b.x)], 1u);
    return b;
}
__device__ __forceinline__ void xcd_barrier_complete(unsigned* bar, unsigned x, unsigned& nloc, unsigned& nx) {
    const unsigned G = gridDim.x * gridDim.y * gridDim.z;
    unsigned sum, cnt, mine, sp = 0u;
    for (;;) {
        sum = 0u; cnt = 0u; mine = 0u;
#pragma unroll
        for (unsigned j = 0; j < 16; ++j) { const unsigned c = xb_ld(&bar[XB_XCNT(j)]); sum += c; cnt += (c > 0u) ? 1u : 0u; mine = (j == x) ? c : mine; }
        if (sum == G) break;
        __builtin_amdgcn_s_sleep(1);
        if ((++sp & 255u) == 0u) { if (xb_ld(&bar[XB_TMO])) break; if (sp > XB_SPIN_CAP) { atomicAdd(&bar[XB_TMO], 1u); break; } }
    }
    nloc = mine > 0u ? mine : 1u; nx = cnt > 0u ? cnt : 1u;
}
__device__ __forceinline__ void xcd_barrier(const XcdBarrier& b) {
    asm volatile("s_waitcnt vmcnt(0)" ::: "memory");
    __syncthreads();
    if (threadIdx.x == 0) {
        unsigned* bar = b.bar;
        __builtin_amdgcn_s_waitcnt(0);
        unsigned nloc = b.st[0], nx = b.st[1];
        if (nloc == 0u) { xcd_barrier_complete(bar, b.x, nloc, nx); b.st[0] = nloc; b.st[1] = nx; }
        const unsigned old = xb_add(&bar[XB_XSUB(b.x)], 1u);
        const unsigned gen = old / nloc;
        if (old + 1u == (gen + 1u) * nloc) {
            __builtin_amdgcn_fence(__ATOMIC_RELEASE, "agent");
            asm volatile("s_waitcnt vmcnt(0)" ::: "memory");
            const unsigned og = xb_add(&bar[XB_TOP], 1u);
            const unsigned tg = og / nx;
            if (og + 1u == (tg + 1u) * nx) xb_add(&bar[XB_TOPGEN], 1u);
            else XB_SPIN(xb_ld(&bar[XB_TOPGEN]) == tg, bar);
            __builtin_amdgcn_fence(__ATOMIC_ACQUIRE, "agent");
            xb_add(&bar[XB_XGEN(b.x)], 1u);
            asm volatile("s_waitcnt vmcnt(0)" ::: "memory");
        } else {
            XB_SPIN(xb_ld(&bar[XB_XGEN(b.x)]) == gen, bar);
            __builtin_amdgcn_fence(__ATOMIC_ACQUIRE, "agent");
            asm volatile("s_waitcnt vmcnt(0)" ::: "memory");
        }
    }
    __syncthreads();
}

constexpr int NPHASE = 11;
__global__ void __launch_bounds__(NTHREADS, 2) mk_fwd(Params P) {
    extern __shared__ __attribute__((aligned(16))) unsigned char lds_raw[];
    LAS unsigned char* lds = (LAS unsigned char*)lds_raw;
    cg::grid_group grid = cg::this_grid();
    const int G = gridDim.x, bid = blockIdx.x, lo = P.lo, hi = P.hi;
    unsigned char* ws = P.ws;
    bf16_t* WINB = (bf16_t*)(ws + WS_WINB); bf16_t* WOUT1 = (bf16_t*)(ws + WS_WOUT1); bf16_t* WG1 = (bf16_t*)(ws + WS_WG1); bf16_t* WP = (bf16_t*)(ws + WS_WP);
    bf16_t* PB = (bf16_t*)(ws + WS_PB); float* STATS = (float*)(ws + WS_STATS); float* KPART = (float*)(ws + WS_KPART); bf16_t* WSB = (bf16_t*)(ws + WS_WSB);
    bf16_t* SLOTA = (bf16_t*)(ws + WS_SLOTA); bf16_t* WINA = (bf16_t*)(ws + WS_WINA); bf16_t* WOUT0 = (bf16_t*)(ws + WS_WOUT0); bf16_t* WG0 = (bf16_t*)(ws + WS_WG0);
    bf16_t* Ub = (bf16_t*)(ws + WS_U); bf16_t* GVb = (bf16_t*)(ws + WS_GV); bf16_t* SZb = (bf16_t*)(ws + WS_SZ);
    bf16_t* Qb = (bf16_t*)(ws + WS_Q); bf16_t* Kb = (bf16_t*)(ws + WS_K); bf16_t* VTb = (bf16_t*)(ws + WS_VT); bf16_t* Zb = (bf16_t*)(ws + WS_Z);
    bf16_t* PP0 = (bf16_t*)(ws + WS_PP0); bf16_t* PP1 = (bf16_t*)(ws + WS_PP1); bf16_t* X1B = (bf16_t*)(ws + WS_X1B); bf16_t* X3B = (bf16_t*)(ws + WS_X3B); bf16_t* Y1 = (bf16_t*)P.out;
    const float ALPHA = 1.4142135623730951f;
#define IN(k) (lo <= (k) && (k) < hi)
    volatile LAS unsigned* xst = (volatile LAS unsigned*)(lds + LDS_MAIN);
    if (threadIdx.x == 0) { xst[0] = 0u; xst[1] = 0u; }
    __syncthreads();
    XcdBarrier xbar; xbar.bar = (unsigned*)(ws + WS_BAR); xbar.x = 0; xbar.st = xst;
    if (hi - lo > 1) xbar = xcd_barrier_post((unsigned*)(ws + WS_BAR), xst);
    if (hi > NPHASE) grid.sync();
#define SEAM(k) do { if (IN(k) && hi > (k) + 1) xcd_barrier(xbar); } while (0)

    if (IN(0)) {
        transpose_convert(lds, P.w_in_b, WINB, 2048, 8192, G, bid);
        transpose_convert(lds, P.w_out, WOUT0, 2048, 2048, G, bid);
        transpose_convert(lds, P.w_out + (size_t)2048 * 2048, WOUT1, 2048, 2048, G, bid);
        transpose_convert(lds, P.w_gate, WG0, 2048, 2048, G, bid);
        transpose_convert(lds, P.w_gate + (size_t)2048 * 2048, WG1, 2048, 2048, G, bid);
        transpose_convert(lds, P.w_proj, WP, 256, 2048, G, bid);
        transpose_convert(lds, P.w_proj + (size_t)256 * 2048, WP + (size_t)2048 * 256, 256, 2048, G, bid);
        convert_flat(P.p, PB, (size_t)2 * MTOK * 256, G, bid);
        for (int i = bid * NTHREADS + threadIdx.x; i < 16 * 128 * 128; i += G * NTHREADS) { const int s = i & 127, t = (i >> 7) & 127; WSB[i] = (bf16_t)(cvt_pk_bf16(s <= t ? P.w_s[i] : 0.f, 0.f) & 0xffffu); }
        transpose_convert<true>(lds, P.w_in_a, WINA, 2048, 6144, G, bid);
        convert_flat(P.x, SLOTA, (size_t)MTOK * DM, G, bid);
    }
    SEAM(0);
    if (IN(1)) {
        pg8::Gemm g{SLOTA, WINA, MTOK, 6144, 2048, 1 << 30, 0}; pg8::StaticOrder S; S.init(MTOK, 6144, G, bid);
        EpiL0In E{Ub, GVb, STATS};
        pg8::gemm_phase<EpiL0In, true>(lds, g, S, E);
    }
    SEAM(1);
    if (IN(2)) sgu_phase(lds, Ub, GVb, SZb, STATS, P.sgu_g, P.sgu_b, WSB, P.b_s, Y1, G, bid);
    SEAM(2);
    if (IN(3)) {
        { pg8::Gemm g{PB, WP, 2 * MTOK, 2048, 256, 32, 8}; pg8::StaticOrder S; S.init(2 * MTOK, 2048, G, bid);
          EpiPlain E{PP0, (long long)((WS_PP1 - WS_PP0) / 2)}; pg8::gemm_phase(lds, g, S, E); }
        { pg8::Gemm g{Y1, WOUT0, MTOK, 2048, 2048, 1 << 30, 0}; pg8::StaticOrder S; S.init(MTOK, 2048, G, bid);
          EpiResLn<true> E{SLOTA, X1B, P.ln_g, P.ln_b, ws, 0, 0}; pg8::gemm_phase(lds, g, S, E); }
    }
    SEAM(3);
    if (IN(5)) {
        pg8::Gemm g{X1B, WG0, MTOK, 2048, 2048, 1 << 30, 0}; pg8::StaticOrder S; S.init(MTOK, 2048, G, bid);
        EpiPle<false> E{X1B, PP0, SLOTA, nullptr}; pg8::gemm_phase<EpiPle<false>, true>(lds, g, S, E);
    }
    SEAM(5);
    if (IN(6)) {
        pg8::Gemm g{SLOTA, WINB, MTOK, 8192, 2048, 1 << 30, 0}; pg8::StaticOrder S; S.init(MTOK, 8192, G, bid);
        EpiL1In E{Qb, Kb, VTb, Zb, KPART}; pg8::gemm_phase<EpiL1In, true>(lds, g, S, E);
    }
    SEAM(6);
    if (IN(7)) attn_phase(lds, Qb, Kb, VTb, Zb, KPART, Y1, G, bid);
    SEAM(7);
    if (IN(8)) {
        { pg8::Gemm g{Y1, WOUT1, MTOK, 2048, 2048, 1 << 30, 0}; pg8::StaticOrder S; S.init(MTOK, 2048, G, bid);
          EpiResLn<true> E{SLOTA, X3B, P.ln_g + DM, P.ln_b + DM, ws, 1, 0}; pg8::gemm_phase(lds, g, S, E); }
    }
    SEAM(8);
    if (IN(10)) {
        pg8::Gemm g{X3B, WG1, MTOK, 2048, 2048, 1 << 30, 0}; pg8::StaticOrder S; S.init(MTOK, 2048, G, bid);
        EpiPle<true> E{X3B, PP1, nullptr, P.out}; pg8::gemm_phase<EpiPle<true>, true>(lds, g, S, E);
    }
#undef IN
#undef SEAM
}

extern "C" void kernel_launch(void* const* d_in, const int* in_sizes, int n_in, void* d_out, int out_size, void* d_ws, size_t ws_size, hipStream_t stream) {
    static int grid_blocks = 0;
    if (grid_blocks == 0) {
        if (n_in != 13 || out_size != MTOK * DM || ws_size < WS_END) { fprintf(stderr, "kernel_launch: unexpected shapes (n_in %d out %d ws %zu)\n", n_in, out_size, ws_size); grid_blocks = -1; return; }
        int dev = 0, cus = 0, per_cu = 0;
        hipGetDevice(&dev);
        hipDeviceGetAttribute(&cus, hipDeviceAttributeMultiprocessorCount, dev);
        if (hipFuncSetAttribute((const void*)mk_fwd, hipFuncAttributeMaxDynamicSharedMemorySize, LDS_BYTES) != hipSuccess) { fprintf(stderr, "kernel_launch: hipFuncSetAttribute failed\n"); grid_blocks = -1; return; }
        if (hipOccupancyMaxActiveBlocksPerMultiprocessor(&per_cu, (const void*)mk_fwd, NTHREADS, LDS_BYTES) != hipSuccess || per_cu < 1) { fprintf(stderr, "kernel_launch: occupancy query failed (%d)\n", per_cu); grid_blocks = -1; return; }
        grid_blocks = cus;
    }
    if (grid_blocks < 0) return;
    if (hipMemsetAsync((unsigned char*)d_ws + WS_BAR, 0, 16384 + 32768, stream) != hipSuccess) { fprintf(stderr, "kernel_launch: memset of the barrier words failed\n"); return; }
    Params p{};
    p.x = (const float*)d_in[0]; p.p = (const float*)d_in[1]; p.w_in_a = (const float*)d_in[2]; p.sgu_g = (const float*)d_in[3]; p.sgu_b = (const float*)d_in[4];
    p.w_s = (const float*)d_in[5]; p.b_s = (const float*)d_in[6]; p.w_in_b = (const float*)d_in[7]; p.w_out = (const float*)d_in[8]; p.ln_g = (const float*)d_in[9];
    p.ln_b = (const float*)d_in[10]; p.w_gate = (const float*)d_in[11]; p.w_proj = (const float*)d_in[12];
    p.out = (float*)d_out; p.ws = (unsigned char*)d_ws;
#if ONE_LAUNCH
    p.lo = 0; p.hi = NPHASE;
    void* args[] = {&p};
    hipError_t e = hipLaunchCooperativeKernel((const void*)mk_fwd, dim3(grid_blocks), dim3(NTHREADS), args, LDS_BYTES, stream);
    if (e != hipSuccess) fprintf(stderr, "cooperative launch failed: %s (grid %d)\n", hipGetErrorString(e), grid_blocks);
#else
    for (int k = 0; k < NPHASE; ++k) {
        p.lo = k; p.hi = k + 1;
        hipLaunchKernelGGL(mk_fwd, dim3(grid_blocks), dim3(NTHREADS), LDS_BYTES, stream, p);
    }
#endif
}
```

```cpp
#include <hip/hip_runtime.h>
#include <hip/hip_cooperative_groups.h>
#include <cstdio>
namespace cg = cooperative_groups;

#ifndef ONE_LAUNCH
#define ONE_LAUNCH 1
#endif

#define LAS __attribute__((address_space(3)))
typedef unsigned short bf16_t;
typedef short bf16x8 __attribute__((ext_vector_type(8)));
typedef float f32x4 __attribute__((ext_vector_type(4)));
typedef float f32x2 __attribute__((ext_vector_type(2)));
typedef float f32x16 __attribute__((ext_vector_type(16)));
typedef unsigned u32x4 __attribute__((ext_vector_type(4)));
typedef unsigned u32x2 __attribute__((ext_vector_type(2)));

constexpr int MTOK = 8192, DM = 2048, SEQ = 2048;
constexpr int NTHREADS = 512;
constexpr int LDS_MAIN = 131072, LDS_BYTES = LDS_MAIN + 16;
constexpr size_t TT = 33554432ull;
constexpr size_t WS_WINB = 0, WS_WOUT1 = TT, WS_WG1 = TT + TT / 4, WS_WP = TT + TT / 2, WS_PB = WS_WP + TT / 16, WS_MISC = WS_PB + TT / 4;
constexpr size_t WS_STATS = WS_MISC, WS_KPART = WS_MISC + (2u << 20), WS_WSB = WS_KPART + (512u << 10), WS_BAR = WS_WSB + (512u << 10), WS_CNT = WS_BAR + 16384, WS_SLOTS = WS_CNT + 32768;
constexpr size_t WS_SLOTA = 2 * TT, WS_WINA = 3 * TT, WS_WOUT0 = 3 * TT + 3 * (TT / 4), WS_WG0 = 4 * TT, WS_U = 4 * TT + TT / 4, WS_GV = WS_U + TT, WS_SZ = WS_GV + TT;
constexpr size_t WS_Q = 3 * TT, WS_K = 4 * TT, WS_VT = 5 * TT, WS_Z = 6 * TT, WS_PP1 = 7 * TT, WS_X3B = 4 * TT, WS_PP0 = WS_U, WS_X1B = WS_GV;
constexpr size_t WS_END = 8 * TT;
static_assert(WS_SZ + TT <= WS_END && WS_WSB + (512u << 10) <= WS_SLOTA && WS_GV == WS_U + TT && WS_SZ == WS_U + 2 * TT && WS_K == WS_Q + TT && WS_VT == WS_Q + 2 * TT && WS_Z == WS_Q + 3 * TT, "workspace map");

struct Params {
    const float* x; const float* p; const float* w_in_a; const float* sgu_g; const float* sgu_b; const float* w_s; const float* b_s; const float* w_in_b;
    const float* w_out; const float* ln_g; const float* ln_b; const float* w_gate; const float* w_proj;
    float* out; unsigned char* ws; int lo, hi;
};

__device__ __forceinline__ unsigned cvt_pk_bf16(float lo, float hi) { unsigned r; asm volatile("v_cvt_pk_bf16_f32 %0, %1, %2" : "=v"(r) : "v"(lo), "v"(hi)); return r; }
__device__ __forceinline__ unsigned cvt_pk_bf16_t(float lo, float hi) { unsigned r; asm volatile("s_nop 1\n\tv_cvt_pk_bf16_f32 %0, %1, %2" : "=v"(r) : "v"(lo), "v"(hi)); return r; }
__device__ __forceinline__ float bf_lo(unsigned w) { return __uint_as_float(w << 16); }
__device__ __forceinline__ float bf_hi(unsigned w) { return __uint_as_float(w & 0xffff0000u); }
__device__ __forceinline__ float fast_sigmoid(float v) { return __builtin_amdgcn_rcpf(1.0f + __builtin_amdgcn_exp2f(-1.4426950408889634f * v)); }
__device__ __forceinline__ float silu_f(float v) { return v * fast_sigmoid(v); }
__device__ __forceinline__ float gelu_f(float v) { const float u = 1.5957691216057308f * (v + 0.044715f * v * v * v); return v * fast_sigmoid(u); }

namespace pg8 {
constexpr int BM = 256, BK = 64, HALF = 128, HTB = HALF * BK * 2, STAGE_BYTES = 8 * HTB, NXCD = 8, WGM = 4;
__host__ __device__ __forceinline__ int lds_byte(int r, int c) { const int st = (r >> 4) * 2 + (c >> 5), rr = r & 15, cc = c & 31, ob = rr * 64 + cc * 2; return st * 1024 + (ob ^ (((ob >> 9) & 1) << 5)); }
__host__ __device__ __forceinline__ void stage_rc(int b, int& R, int& C) { const int st = b / 1024, sb = b % 1024, swz = sb ^ (((sb >> 9) & 1) << 5); R = (st >> 1) * 16 + swz / 64; C = (st & 1) * 32 + (swz % 64) / 2; }
__host__ __device__ __forceinline__ int perm32(int rho) { const int n = rho >> 4, i = rho & 15; return 8 * (i >> 2) + 4 * n + (i & 3); }
struct Unit { int pm, pn; };
struct Gemm { const bf16_t* A; const bf16_t* Bt; int M, N, K; int bsplit, badd; };
struct StaticOrder {
    int nM, nN, nwg, G, c;
    __device__ void init(int M, int N, int G_, int c_) { nM = M / BM; nN = N / BM; nwg = nM * nN; G = G_; c = c_; }
    __device__ bool next(int i, Unit& u) const {
        const long L = (long)i * G + c; if (L >= nwg) return false;
        int wgid = (int)L; { const int q = nwg / NXCD, r = nwg % NXCD, xcd = wgid % NXCD, off = wgid / NXCD; wgid = (xcd < r ? xcd * (q + 1) : r * (q + 1) + (xcd - r) * q) + off; }
        const int nig = WGM * nN, gid = wgid / nig, fm = gid * WGM, gsz = (nM - fm) < WGM ? (nM - fm) : WGM;
        u.pm = fm + ((wgid % nig) % gsz); u.pn = (wgid % nig) / gsz; return true;
    }
};
template <class Epi, bool ALIGN_EPI = false, bool SP2 = true>
__device__ __forceinline__ void gemm_phase(LAS unsigned char* lds, const Gemm g, const StaticOrder& S, const Epi& E) {
    const int tid = threadIdx.x, wid = __builtin_amdgcn_readfirstlane(tid >> 6), lane = tid & 63, wr = wid >> 2, wc = wid & 3, fr = lane & 15, fq = lane >> 4;
    const int K = g.K, nt = K / BK;
    unsigned voffA[2], voffB[2];
#pragma unroll
    for (int i = 0; i < 2; ++i) { int R, C; stage_rc(tid * 16 + i * 8192, R, C); const int Rb = (R & ~31) + perm32(R & 31);
        voffA[i] = (unsigned)(R * K + C) * 2u; voffB[i] = (unsigned)(Rb * K + C) * 2u; }
    const size_t kstep = (size_t)(BK * 2);
    const size_t hstep = (size_t)HALF * K * 2;
    const size_t tstep = 2 * hstep;
    const unsigned ldsw = (unsigned)wid * 1024u;
    const int aoff = lds_byte(wr * 64 + fr, fq * 8), boff = lds_byte(wc * 32 + fr, fq * 8);
#define PG8_SA(b, h) (((b) * 2 + (h)) * HTB)
#define PG8_SB(b, h) ((4 + (b) * 2 + (h)) * HTB)
#define PG8_STAGE(bufoff, gbase, voff) do { _Pragma("unroll") for (int _i = 0; _i < 2; ++_i) \
        __builtin_amdgcn_global_load_lds((const unsigned*)((const char*)(gbase) + (voff)[_i]), (LAS unsigned*)(lds + (bufoff) + ldsw + _i * 8192), 16, 0, 0); } while (0)
#define PG8_LDA(dst, b, h) do { _Pragma("unroll") for (int m = 0; m < 4; ++m) _Pragma("unroll") for (int k = 0; k < 2; ++k) dst[m][k] = *(const LAS bf16x8*)(lds + PG8_SA(b, h) + aoff + m * 2048 + k * 1024); } while (0)
#define PG8_LDB(dst, b, h) do { _Pragma("unroll") for (int n = 0; n < 2; ++n) _Pragma("unroll") for (int k = 0; k < 2; ++k) dst[n][k] = *(const LAS bf16x8*)(lds + PG8_SB(b, h) + boff + n * 2048 + k * 1024); } while (0)
#define PG8_MMA(ai, bj, At, Bt) do { __builtin_amdgcn_s_setprio(1); _Pragma("unroll") for (int m = 0; m < 4; ++m) _Pragma("unroll") for (int n = 0; n < 2; ++n) _Pragma("unroll") for (int k = 0; k < 2; ++k) \
        acc[ai][bj][m][n] = __builtin_amdgcn_mfma_f32_16x16x32_bf16(Bt[n][k], At[m][k], acc[ai][bj][m][n], 0, 0, 0); __builtin_amdgcn_s_setprio(0); } while (0)
#define PG8_WAIT_V(n) asm volatile("s_waitcnt vmcnt(" #n ")" ::: "memory")
#define PG8_WAIT_L(n) asm volatile("s_waitcnt lgkmcnt(" #n ")" ::: "memory")
#define PG8_BAR __builtin_amdgcn_s_barrier()
#define PG8_SCHED __builtin_amdgcn_sched_barrier(0)
    Unit cur, nxt; int ui = 0;
    if (!S.next(0, cur)) return;
    f32x4 acc[2][2][4][2];
#pragma unroll
    for (int a = 0; a < 2; ++a)
#pragma unroll
        for (int b = 0; b < 2; ++b)
#pragma unroll
            for (int m = 0; m < 4; ++m)
#pragma unroll
                for (int n = 0; n < 2; ++n) acc[a][b][m][n] = (f32x4){0.f, 0.f, 0.f, 0.f};
    bf16x8 At[4][2], B0[2][2], B1[2][2];
    const char* cA = (const char*)g.A + (size_t)cur.pm * tstep; const char* cB = (const char*)g.Bt + (size_t)(cur.pn + (cur.pm >= g.bsplit ? g.badd : 0)) * tstep;
    if constexpr (SP2) {
        PG8_STAGE(PG8_SB(0, 0), cB, voffB); PG8_STAGE(PG8_SB(0, 1), cB + hstep, voffB); PG8_STAGE(PG8_SA(0, 0), cA, voffA); PG8_STAGE(PG8_SA(0, 1), cA + hstep, voffA);
        if (wr == 1) PG8_BAR;
        PG8_WAIT_V(2); PG8_BAR;
        PG8_STAGE(PG8_SB(1, 0), cB + kstep, voffB); PG8_STAGE(PG8_SA(1, 0), cA + kstep, voffA); PG8_STAGE(PG8_SB(1, 1), cB + hstep + kstep, voffB);
        PG8_WAIT_V(6); PG8_BAR;
    } else {
        PG8_STAGE(PG8_SB(0, 0), cB, voffB); PG8_STAGE(PG8_SA(0, 0), cA, voffA); PG8_STAGE(PG8_SB(0, 1), cB + hstep, voffB); PG8_STAGE(PG8_SA(0, 1), cA + hstep, voffA);
        if (wr == 1) PG8_BAR;
        PG8_WAIT_V(4); PG8_BAR;
        PG8_STAGE(PG8_SB(1, 0), cB + kstep, voffB); PG8_STAGE(PG8_SA(1, 0), cA + kstep, voffA); PG8_STAGE(PG8_SB(1, 1), cB + hstep + kstep, voffB);
        PG8_WAIT_V(6); PG8_BAR;
    }
    for (;;) {
        const bool has_next = S.next(ui + 1, nxt);
        const char* nA = has_next ? (const char*)g.A + (size_t)nxt.pm * tstep : cA; const char* nB = has_next ? (const char*)g.Bt + (size_t)(nxt.pn + (nxt.pm >= g.bsplit ? g.badd : 0)) * tstep : cB;
        for (int t = 0; t < nt; t += 2) {
            const bool last = (t == nt - 2);
            const char* a1 = cA + (size_t)(t + 1) * kstep;
            const char* a2 = last ? nA : cA + (size_t)(t + 2) * kstep; const char* b2 = last ? nB : cB + (size_t)(t + 2) * kstep;
            const char* a3 = a2 + kstep; const char* b3 = b2 + kstep;
            if constexpr (SP2) {
            PG8_LDB(B0, 0, 0); PG8_LDB(B1, 0, 1); PG8_SCHED; PG8_LDA(At, 0, 0); PG8_STAGE(PG8_SA(1, 1), a1 + hstep, voffA);
            PG8_WAIT_V(8); PG8_WAIT_L(0); PG8_BAR; PG8_MMA(0, 0, At, B0); PG8_MMA(0, 1, At, B1); PG8_BAR; PG8_SCHED;
            PG8_LDA(At, 0, 1); PG8_STAGE(PG8_SB(0, 0), b2, voffB); PG8_STAGE(PG8_SB(0, 1), b2 + hstep, voffB); PG8_STAGE(PG8_SA(0, 0), a2, voffA);
            PG8_WAIT_V(8); PG8_WAIT_L(0); PG8_BAR; PG8_MMA(1, 0, At, B0); PG8_MMA(1, 1, At, B1); PG8_BAR; PG8_SCHED;
            PG8_LDB(B0, 1, 0); PG8_LDB(B1, 1, 1); PG8_SCHED; PG8_LDA(At, 1, 0); PG8_STAGE(PG8_SA(0, 1), a2 + hstep, voffA);
            PG8_WAIT_V(8); PG8_WAIT_L(0); PG8_BAR; PG8_MMA(0, 0, At, B0); PG8_MMA(0, 1, At, B1); PG8_BAR; PG8_SCHED;
            PG8_LDA(At, 1, 1); PG8_STAGE(PG8_SB(1, 0), b3, voffB); PG8_STAGE(PG8_SB(1, 1), b3 + hstep, voffB); PG8_STAGE(PG8_SA(1, 0), a3, voffA);
            PG8_WAIT_V(8); PG8_WAIT_L(0); PG8_BAR; PG8_MMA(1, 0, At, B0); PG8_MMA(1, 1, At, B1); PG8_BAR; PG8_SCHED;
            } else {
            PG8_LDB(B0, 0, 0); PG8_SCHED; PG8_LDA(At, 0, 0); PG8_STAGE(PG8_SA(1, 1), a1 + hstep, voffA);
            PG8_WAIT_L(8); PG8_BAR; PG8_WAIT_L(0); PG8_MMA(0, 0, At, B0); PG8_BAR; PG8_SCHED;
            PG8_LDB(B1, 0, 1); PG8_STAGE(PG8_SB(0, 0), b2, voffB);
            PG8_BAR; PG8_WAIT_L(0); PG8_MMA(0, 1, At, B1); PG8_BAR;
            PG8_LDA(At, 0, 1); PG8_STAGE(PG8_SA(0, 0), a2, voffA);
            PG8_BAR; PG8_WAIT_L(0); PG8_MMA(1, 0, At, B0); PG8_BAR; PG8_SCHED;
            PG8_STAGE(PG8_SB(0, 1), b2 + hstep, voffB);
            PG8_WAIT_V(6); PG8_BAR; PG8_MMA(1, 1, At, B1); PG8_BAR;
            PG8_LDB(B0, 1, 0); PG8_SCHED; PG8_LDA(At, 1, 0); PG8_STAGE(PG8_SA(0, 1), a2 + hstep, voffA);
            PG8_WAIT_L(8); PG8_BAR; PG8_WAIT_L(0); PG8_MMA(0, 0, At, B0); PG8_BAR; PG8_SCHED;
            PG8_LDB(B1, 1, 1); PG8_STAGE(PG8_SB(1, 0), b3, voffB);
            PG8_BAR; PG8_WAIT_L(0); PG8_MMA(0, 1, At, B1); PG8_BAR;
            PG8_LDA(At, 1, 1); PG8_STAGE(PG8_SA(1, 0), a3, voffA);
            PG8_BAR; PG8_WAIT_L(0); PG8_MMA(1, 0, At, B0); PG8_BAR; PG8_SCHED;
            PG8_STAGE(PG8_SB(1, 1), b3 + hstep, voffB);
            PG8_WAIT_V(6); PG8_BAR; PG8_MMA(1, 1, At, B1); PG8_BAR;
            }
        }
        if constexpr (ALIGN_EPI) { if (wr == 0) PG8_BAR; }
        if constexpr (!Epi::AFTER_DRAIN) E(acc, cur, wr, wc, fr, fq);
        if (!has_next) break;
#pragma unroll
        for (int a = 0; a < 2; ++a)
#pragma unroll
            for (int b = 0; b < 2; ++b)
#pragma unroll
                for (int m = 0; m < 4; ++m)
#pragma unroll
                    for (int n = 0; n < 2; ++n) acc[a][b][m][n] = (f32x4){0.f, 0.f, 0.f, 0.f};
        cur = nxt; cA = nA; cB = nB; ++ui;
        if constexpr (ALIGN_EPI) { if (wr == 1) PG8_BAR; }
    }
    PG8_WAIT_V(0);
    if constexpr (!ALIGN_EPI) { if (wr == 0) PG8_BAR; }
    PG8_BAR;
    if constexpr (Epi::AFTER_DRAIN) E.fused(acc, cur, wr, wc, fr, fq, lds, wid, lane);
#undef PG8_SA
#undef PG8_SB
#undef PG8_STAGE
#undef PG8_LDA
#undef PG8_LDB
#undef PG8_MMA
#undef PG8_WAIT_V
#undef PG8_WAIT_L
#undef PG8_BAR
#undef PG8_SCHED
}
}
using pg8::Unit;
typedef f32x4 Acc[2][2][4][2];

__device__ __forceinline__ u32x4 pack8(const f32x4 a, const f32x4 b) { u32x4 w; w.x = cvt_pk_bf16(a[0], a[1]); w.y = cvt_pk_bf16(a[2], a[3]); w.z = cvt_pk_bf16(b[0], b[1]); w.w = cvt_pk_bf16(b[2], b[3]); return w; }

struct EpiL0In {
    static constexpr bool AFTER_DRAIN = false;
    bf16_t* UZ; bf16_t* GV; float* stats;
    __device__ __forceinline__ void operator()(const Acc& acc, const Unit& u, int wr, int wc, int fr, int fq) const {
        if (u.pn < 16) {
            const int cb = u.pn * 128 + wc * 32 + 8 * fq;
#pragma unroll
            for (int ai = 0; ai < 2; ++ai)
#pragma unroll
                for (int m = 0; m < 4; ++m) {
                    const int row = u.pm * 256 + ai * 128 + wr * 64 + m * 16 + fr;
                    f32x4 a0 = acc[ai][0][m][0], a1 = acc[ai][0][m][1]; const f32x4 z0 = acc[ai][1][m][0], z1 = acc[ai][1][m][1];
#pragma unroll
                    for (int j = 0; j < 4; ++j) { a0[j] = gelu_f(a0[j]) * silu_f(z0[j]); a1[j] = gelu_f(a1[j]) * silu_f(z1[j]); }
                    *(u32x4*)(UZ + (size_t)row * DM + cb) = pack8(a0, a1);
                }
        } else {
            const int pnv = u.pn - 16, cb = pnv * 256 + wc * 32 + 8 * fq;
#pragma unroll
            for (int ai = 0; ai < 2; ++ai)
#pragma unroll
                for (int m = 0; m < 4; ++m) {
                    const int row = u.pm * 256 + ai * 128 + wr * 64 + m * 16 + fr;
                    float s = 0.f, ss = 0.f;
#pragma unroll
                    for (int bj = 0; bj < 2; ++bj) {
                        f32x4 v0 = acc[ai][bj][m][0], v1 = acc[ai][bj][m][1];
#pragma unroll
                        for (int j = 0; j < 4; ++j) { v0[j] = gelu_f(v0[j]); v1[j] = gelu_f(v1[j]); }
#pragma unroll
                        for (int j = 0; j < 4; ++j) { s += v0[j] + v1[j]; ss += v0[j] * v0[j] + v1[j] * v1[j]; }
                        *(u32x4*)(GV + (size_t)row * DM + cb + bj * 128) = pack8(v0, v1);
                    }
                    s += __shfl_xor(s, 16); s += __shfl_xor(s, 32); ss += __shfl_xor(ss, 16); ss += __shfl_xor(ss, 32);
                    if (fq == 0) *(f32x2*)(stats + ((size_t)row * 32 + pnv * 4 + wc) * 2) = (f32x2){s, ss};
                }
        }
    }
};
struct EpiPlain {
    static constexpr bool AFTER_DRAIN = false;
    bf16_t* O; long long delta2;
    __device__ __forceinline__ void operator()(const Acc& acc, const Unit& u, int wr, int wc, int fr, int fq) const {
        const int cb = u.pn * 256 + wc * 32 + 8 * fq;
        bf16_t* Ob = O + (u.pm >= 32 ? delta2 - (long long)32 * 256 * DM : 0ll);
#pragma unroll
        for (int ai = 0; ai < 2; ++ai)
#pragma unroll
            for (int m = 0; m < 4; ++m) {
                const int row = u.pm * 256 + ai * 128 + wr * 64 + m * 16 + fr;
#pragma unroll
                for (int bj = 0; bj < 2; ++bj) *(u32x4*)(Ob + (size_t)row * DM + cb + bj * 128) = pack8(acc[ai][bj][m][0], acc[ai][bj][m][1]);
            }
    }
};
struct EpiRes {
    static constexpr bool AFTER_DRAIN = false;
    const float* res; float* out; float* stats; float alpha;
    __device__ __forceinline__ void operator()(const Acc& acc, const Unit& u, int wr, int wc, int fr, int fq) const {
        const int cb = u.pn * 256 + wc * 32 + 8 * fq;
#pragma unroll
        for (int ai = 0; ai < 2; ++ai)
#pragma unroll
            for (int m = 0; m < 4; ++m) {
                const int row = u.pm * 256 + ai * 128 + wr * 64 + m * 16 + fr;
                float s = 0.f, ss = 0.f;
#pragma unroll
                for (int bj = 0; bj < 2; ++bj) {
                    const size_t o = (size_t)row * DM + cb + bj * 128;
                    const f32x4 r0 = *(const f32x4*)(res + o), r1 = *(const f32x4*)(res + o + 4);
                    const f32x4 t0 = r0 * alpha + acc[ai][bj][m][0], t1 = r1 * alpha + acc[ai][bj][m][1];
#pragma unroll
                    for (int j = 0; j < 4; ++j) { s += t0[j] + t1[j]; ss += t0[j] * t0[j] + t1[j] * t1[j]; }
                    *(f32x4*)(out + o) = t0; *(f32x4*)(out + o + 4) = t1;
                }
                s += __shfl_xor(s, 16); s += __shfl_xor(s, 32); ss += __shfl_xor(ss, 16); ss += __shfl_xor(ss, 32);
                if (fq == 0) *(f32x2*)(stats + ((size_t)row * 32 + u.pn * 4 + wc) * 2) = (f32x2){s, ss};
            }
    }
};
template <bool RES_BF16> struct EpiResLn {
    static constexpr bool AFTER_DRAIN = true;
    const void* res; bf16_t* xb; const float* g; const float* b; unsigned char* ws; int layer, pad;
    static constexpr float alpha = 1.4142135623730951f;
    __device__ __forceinline__ void operator()(const Acc&, const Unit&, int, int, int, int) const {}
    __device__ __forceinline__ void fused(Acc& acc, const Unit& u, int wr, int wc, int fr, int fq, LAS unsigned char* lds, int wid, int lane) const {
        const int cb = u.pn * 256 + wc * 32 + 8 * fq;
        LAS f32x2* Pt = (LAS f32x2*)lds;
        LAS f32x2* St = (LAS f32x2*)(lds + 8192);
        unsigned long long* slots = (unsigned long long*)(ws + WS_SLOTS) + (size_t)layer * MTOK * 8; unsigned* cnt = (unsigned*)(ws + WS_CNT) + layer * 64 * 32;
#pragma unroll
        for (int ai = 0; ai < 2; ++ai) {
            const size_t ob = (size_t)(u.pm * 256 + ai * 128 + wr * 64 + fr) * DM + cb;
            f32x4 rr[4][2][2];
#pragma unroll
            for (int m = 0; m < 4; ++m)
#pragma unroll
                for (int bj = 0; bj < 2; ++bj) {
                    const size_t o = ob + (size_t)m * 16 * DM + bj * 128;
                    if constexpr (RES_BF16) { const u32x4 rw = *(const u32x4*)((const bf16_t*)res + o);
                        rr[m][bj][0] = (f32x4){bf_lo(rw.x), bf_hi(rw.x), bf_lo(rw.y), bf_hi(rw.y)}; rr[m][bj][1] = (f32x4){bf_lo(rw.z), bf_hi(rw.z), bf_lo(rw.w), bf_hi(rw.w)}; }
                    else { rr[m][bj][0] = *(const f32x4*)((const float*)res + o); rr[m][bj][1] = *(const f32x4*)((const float*)res + o + 4); }
                }
#pragma unroll
            for (int m = 0; m < 4; ++m) {
                const int rl = ai * 128 + wr * 64 + m * 16 + fr;
                float s = 0.f, ss = 0.f;
#pragma unroll
                for (int bj = 0; bj < 2; ++bj) {
                    const f32x4 t0 = rr[m][bj][0] * alpha + acc[ai][bj][m][0], t1 = rr[m][bj][1] * alpha + acc[ai][bj][m][1];
                    acc[ai][bj][m][0] = t0; acc[ai][bj][m][1] = t1;
#pragma unroll
                    for (int j = 0; j < 4; ++j) { s += t0[j] + t1[j]; ss += t0[j] * t0[j] + t1[j] * t1[j]; }
                }
                s += __shfl_xor(s, 16); s += __shfl_xor(s, 32); ss += __shfl_xor(ss, 16); ss += __shfl_xor(ss, 32);
                if (fq == 0) Pt[rl * 4 + wc] = (f32x2){s, ss};
            }
        }
        asm volatile("s_waitcnt lgkmcnt(0)" ::: "memory"); __builtin_amdgcn_s_barrier(); asm volatile("" ::: "memory");
        const int rowi = wid * 32 + (lane & 31);
        if (lane < 32) {
            const f32x2 a = Pt[rowi * 4 + 0], b2 = Pt[rowi * 4 + 1], c = Pt[rowi * 4 + 2], d = Pt[rowi * 4 + 3];
            const float S = (a.x + b2.x) + (c.x + d.x), SS = (a.y + b2.y) + (c.y + d.y);
            unsigned long long* slot = slots + ((size_t)(u.pm * 256 + rowi) * 8 + u.pn);
            __hip_atomic_store(slot, ((unsigned long long)__float_as_uint(SS) << 32) | __float_as_uint(S), __ATOMIC_RELAXED, __HIP_MEMORY_SCOPE_AGENT);
        }
        asm volatile("s_waitcnt vmcnt(0)" ::: "memory");
        if (lane == 0) __hip_atomic_fetch_add(cnt + 64 * u.pm, 1u, __ATOMIC_RELAXED, __HIP_MEMORY_SCOPE_AGENT);
        if (wid == 0) {
            unsigned sp = 0u;
            while ((unsigned)__builtin_amdgcn_readfirstlane(__hip_atomic_load(cnt + 64 * u.pm, __ATOMIC_RELAXED, __HIP_MEMORY_SCOPE_AGENT)) < 64u) { __builtin_amdgcn_s_sleep(2); if (++sp > (1u << 22)) break; }
            __builtin_amdgcn_fence(__ATOMIC_ACQUIRE, "agent");
        }
        asm volatile("s_waitcnt vmcnt(0) lgkmcnt(0)" ::: "memory"); __builtin_amdgcn_s_barrier(); asm volatile("" ::: "memory");
        if (lane < 32) {
            const unsigned long long* slot = slots + (size_t)(u.pm * 256 + rowi) * 8; float S = 0.f, SS = 0.f;
#pragma unroll
            for (int t = 0; t < 8; ++t) { const unsigned long long w = __hip_atomic_load(slot + t, __ATOMIC_RELAXED, __HIP_MEMORY_SCOPE_AGENT); S += __uint_as_float((unsigned)w); SS += __uint_as_float((unsigned)(w >> 32)); }
            const float mean = S * (1.0f / DM), var = SS * (1.0f / DM) - mean * mean;
            St[rowi] = (f32x2){mean, rsqrtf(var + 1e-5f)};
        }
        asm volatile("s_waitcnt lgkmcnt(0)" ::: "memory"); __builtin_amdgcn_s_barrier(); asm volatile("" ::: "memory");
#pragma unroll
        for (int bj = 0; bj < 2; ++bj) {
            const f32x4 g0 = *(const f32x4*)(g + cb + bj * 128), g1 = *(const f32x4*)(g + cb + bj * 128 + 4), b0 = *(const f32x4*)(b + cb + bj * 128), b1 = *(const f32x4*)(b + cb + bj * 128 + 4);
#pragma unroll
            for (int ai = 0; ai < 2; ++ai)
#pragma unroll
                for (int m = 0; m < 4; ++m) {
                    const int rl = ai * 128 + wr * 64 + m * 16 + fr;
                    const f32x2 st = St[rl];
                    const size_t o = (size_t)(u.pm * 256 + rl) * DM + cb + bj * 128;
                    const f32x4 o0 = (acc[ai][bj][m][0] - st.x) * st.y * g0 + b0, o1 = (acc[ai][bj][m][1] - st.x) * st.y * g1 + b1;
                    *(u32x4*)(xb + o) = pack8(o0, o1);
                }
        }
    }
};
template <bool OUT_F32> struct EpiPle {
    static constexpr bool AFTER_DRAIN = false;
    const bf16_t* xin; const bf16_t* pp; bf16_t* xb; float* outf;
    __device__ __forceinline__ void operator()(const Acc& acc, const Unit& u, int wr, int wc, int fr, int fq) const {
        const int cb = u.pn * 256 + wc * 32 + 8 * fq;
#pragma unroll
        for (int ai = 0; ai < 2; ++ai) {
            const size_t o0 = (size_t)(u.pm * 256 + ai * 128 + wr * 64 + fr) * DM + cb;
            u32x4 xw[4][2], pw[4][2];
#pragma unroll
            for (int m = 0; m < 4; ++m)
#pragma unroll
                for (int bj = 0; bj < 2; ++bj) { const size_t o = o0 + (size_t)m * 16 * DM + bj * 128; xw[m][bj] = *(const u32x4*)(xin + o); pw[m][bj] = *(const u32x4*)(pp + o); }
#pragma unroll
            for (int m = 0; m < 4; ++m)
#pragma unroll
                for (int bj = 0; bj < 2; ++bj) {
                    const size_t o = o0 + (size_t)m * 16 * DM + bj * 128;
                    const u32x4 x = xw[m][bj], p = pw[m][bj];
                    const f32x4 a0 = acc[ai][bj][m][0], a1 = acc[ai][bj][m][1];
                    f32x4 r0, r1;
                    r0[0] = bf_lo(x.x) + fast_sigmoid(a0[0]) * bf_lo(p.x); r0[1] = bf_hi(x.x) + fast_sigmoid(a0[1]) * bf_hi(p.x);
                    r0[2] = bf_lo(x.y) + fast_sigmoid(a0[2]) * bf_lo(p.y); r0[3] = bf_hi(x.y) + fast_sigmoid(a0[3]) * bf_hi(p.y);
                    r1[0] = bf_lo(x.z) + fast_sigmoid(a1[0]) * bf_lo(p.z); r1[1] = bf_hi(x.z) + fast_sigmoid(a1[1]) * bf_hi(p.z);
                    r1[2] = bf_lo(x.w) + fast_sigmoid(a1[2]) * bf_lo(p.w); r1[3] = bf_hi(x.w) + fast_sigmoid(a1[3]) * bf_hi(p.w);
                    if constexpr (OUT_F32) { *(f32x4*)(outf + o) = r0; *(f32x4*)(outf + o + 4) = r1; }
                    else *(u32x4*)(xb + o) = pack8(r0, r1);
                }
        }
    }
};
struct EpiL1In {
    static constexpr bool AFTER_DRAIN = false;
    bf16_t* Q; bf16_t* Kb; bf16_t* VT; bf16_t* Z; float* kpart;
    __device__ __forceinline__ void operator()(const Acc& acc, const Unit& u, int wr, int wc, int fr, int fq) const {
        const int type = u.pn >> 3, cb = (u.pn & 7) * 256 + wc * 32 + 8 * fq;
        if (type == 2) {
            const int b = u.pm >> 3, sb = (u.pm & 7) * 256 + wr * 64;
            const int pos = (fr < 4 || fr >= 12) ? fr : (fr < 8 ? fr + 4 : fr - 4);
#pragma unroll
            for (int bj = 0; bj < 2; ++bj)
#pragma unroll
                for (int n = 0; n < 2; ++n)
#pragma unroll
                    for (int j = 0; j < 4; ++j) {
                        const int c = cb + bj * 128 + 4 * n + j, h = c >> 7, d = c & 127;
                        bf16_t* base = VT + ((size_t)((b * 16 + h) * 128 + d)) * SEQ + sb + pos;
#pragma unroll
                        for (int ai = 0; ai < 2; ++ai)
#pragma unroll
                            for (int m = 0; m < 4; ++m) base[ai * 128 + m * 16] = (bf16_t)(cvt_pk_bf16(acc[ai][bj][m][n][j], 0.f) & 0xffffu);
                    }
            return;
        }
        bf16_t* O = Q + (size_t)type * (TT / 2);
        const float qs = 0.08838834764831845f * 1.4426950408889634f;
#pragma unroll
        for (int ai = 0; ai < 2; ++ai)
#pragma unroll
            for (int m = 0; m < 4; ++m) {
                const int row = u.pm * 256 + ai * 128 + wr * 64 + m * 16 + fr;
#pragma unroll
                for (int bj = 0; bj < 2; ++bj) {
                    f32x4 v0 = acc[ai][bj][m][0], v1 = acc[ai][bj][m][1];
                    if (type == 0) { v0 *= qs; v1 *= qs; }
                    if (type == 3) {
#pragma unroll
                        for (int j = 0; j < 4; ++j) { v0[j] = silu_f(v0[j]); v1[j] = silu_f(v1[j]); }
                    }
                    *(u32x4*)(O + (size_t)row * DM + cb + bj * 128) = pack8(v0, v1);
                }
            }
        if (type == 1) {
            float* kp = kpart + ((size_t)(u.pm * 2 + wr)) * DM;
#pragma unroll
            for (int bj = 0; bj < 2; ++bj)
#pragma unroll
                for (int n = 0; n < 2; ++n) {
                    f32x4 cs = (f32x4){0.f, 0.f, 0.f, 0.f};
#pragma unroll
                    for (int ai = 0; ai < 2; ++ai)
#pragma unroll
                        for (int m = 0; m < 4; ++m) cs += acc[ai][bj][m][n];
#pragma unroll
                    for (int j = 0; j < 4; ++j) { float v = cs[j]; v += __shfl_xor(v, 1); v += __shfl_xor(v, 2); v += __shfl_xor(v, 4); v += __shfl_xor(v, 8); cs[j] = v; }
                    if (fr == 0) *(f32x4*)(kp + cb + bj * 128 + 4 * n) = cs;
                }
        }
    }
};

template <bool REMAP = false>
__device__ __forceinline__ void transpose_convert(LAS unsigned char* lds, const float* src, bf16_t* dst, int K, int N, int G, int bid) {
    LAS float* tile = (LAS float*)lds;
    const int tid = threadIdx.x, ntn = N / 64, ntiles = (K / 128) * ntn;
    const int r0 = tid >> 4, c4 = tid & 15;
    f32x4 v[4];
    if (bid < ntiles) { const int k0 = (bid / ntn) * 128, n0 = (bid % ntn) * 64;
#pragma unroll
        for (int i = 0; i < 4; ++i) v[i] = __builtin_nontemporal_load((const f32x4*)(src + (size_t)(k0 + r0 + 32 * i) * N + n0 + c4 * 4)); }
    for (int t = bid; t < ntiles; t += G) {
        const int k0 = (t / ntn) * 128, n0 = (t % ntn) * 64;
        asm volatile("s_waitcnt lgkmcnt(0)" ::: "memory"); __builtin_amdgcn_s_barrier(); asm volatile("" ::: "memory");
#pragma unroll
        for (int i = 0; i < 4; ++i) {
#pragma unroll
            for (int j = 0; j < 4; ++j) tile[(r0 + 32 * i) * 65 + c4 * 4 + j] = v[i][j]; }
        asm volatile("s_waitcnt lgkmcnt(0)" ::: "memory"); __builtin_amdgcn_s_barrier(); asm volatile("" ::: "memory");
        if (t + G < ntiles) { const int k1 = ((t + G) / ntn) * 128, n1 = ((t + G) % ntn) * 64;
#pragma unroll
            for (int i = 0; i < 4; ++i) v[i] = __builtin_nontemporal_load((const f32x4*)(src + (size_t)(k1 + r0 + 32 * i) * N + n1 + c4 * 4)); }
#pragma unroll
        for (int i = 0; i < 2; ++i) { const int id = tid + 512 * i, n = id >> 4, kc = id & 15;
            float f[8];
#pragma unroll
            for (int j = 0; j < 8; ++j) f[j] = tile[(kc * 8 + j) * 65 + n];
            u32x4 w; w.x = cvt_pk_bf16(f[0], f[1]); w.y = cvt_pk_bf16(f[2], f[3]); w.z = cvt_pk_bf16(f[4], f[5]); w.w = cvt_pk_bf16(f[6], f[7]);
            const int nd = !REMAP ? n0 : (n0 < 2048 ? (n0 >> 7) * 256 + (n0 & 127) : (n0 < 4096 ? n0 + 2048 : ((n0 - 4096) >> 7) * 256 + 128 + (n0 & 127)));
            *(u32x4*)(dst + (size_t)(nd + n) * K + k0 + kc * 8) = w; }
    }
    __syncthreads();
}
__device__ __forceinline__ void convert_rows_xcd(const float* src, bf16_t* dst, int G, int bid) {
    const size_t per = (size_t)MTOK * DM / 8 / 8;
    const size_t base = (size_t)(bid & 7) * per, stride = (size_t)(G >> 3) * NTHREADS;
    for (size_t j = (size_t)(bid >> 3) * NTHREADS + threadIdx.x; j + 3 * stride < per + 3 * stride && j < per; j += 4 * stride) {
        f32x4 a[4], b[4];
#pragma unroll
        for (int u = 0; u < 4; ++u) { const size_t i = base + j + u * stride; if (j + u * stride < per) { a[u] = __builtin_nontemporal_load((const f32x4*)(src + i * 8)); b[u] = __builtin_nontemporal_load((const f32x4*)(src + i * 8 + 4)); } }
#pragma unroll
        for (int u = 0; u < 4; ++u) { const size_t i = base + j + u * stride; if (j + u * stride < per) *(u32x4*)(dst + i * 8) = pack8(a[u], b[u]); }
    }
}
__device__ __forceinline__ void convert_flat(const float* src, bf16_t* dst, size_t n, int G, int bid) {
    const size_t n8 = n / 8, stride = (size_t)G * NTHREADS;
    size_t i = (size_t)bid * NTHREADS + threadIdx.x;
    for (; i + 3 * stride < n8; i += 4 * stride) {
        f32x4 a[4], b[4];
#pragma unroll
        for (int u = 0; u < 4; ++u) { a[u] = __builtin_nontemporal_load((const f32x4*)(src + (i + u * stride) * 8)); b[u] = __builtin_nontemporal_load((const f32x4*)(src + (i + u * stride) * 8 + 4)); }
#pragma unroll
        for (int u = 0; u < 4; ++u) *(u32x4*)(dst + (i + u * stride) * 8) = pack8(a[u], b[u]);
    }
    for (; i < n8; i += stride) {
        const f32x4 a = __builtin_nontemporal_load((const f32x4*)(src + i * 8)), b = __builtin_nontemporal_load((const f32x4*)(src + i * 8 + 4));
        *(u32x4*)(dst + i * 8) = pack8(a, b);
    }
}

__device__ __forceinline__ void ln_apply_phase(float* xf, const float* stats, const float* g, const float* bta, bf16_t* xb, int G, int bid) {
    const int wid = threadIdx.x >> 6, lane = threadIdx.x & 63;
    for (int row = bid * 8 + wid; row < MTOK; row += G * 8) {
        float s = 0.f, ss = 0.f;
        if (lane < 32) { const f32x2 pr = *(const f32x2*)(stats + ((size_t)row * 32 + lane) * 2); s = pr.x; ss = pr.y; }
#pragma unroll
        for (int o = 32; o >= 1; o >>= 1) { s += __shfl_xor(s, o); ss += __shfl_xor(ss, o); }
        const float mean = s * (1.0f / DM), var = ss * (1.0f / DM) - mean * mean, rstd = rsqrtf(var + 1e-5f);
        float* xr = xf + (size_t)row * DM;
#pragma unroll
        for (int i = 0; i < 4; ++i) {
            const int c = i * 512 + lane * 8;
            const f32x4 t0 = *(const f32x4*)(xr + c), t1 = *(const f32x4*)(xr + c + 4);
            const f32x4 g0 = *(const f32x4*)(g + c), g1 = *(const f32x4*)(g + c + 4), b0 = *(const f32x4*)(bta + c), b1 = *(const f32x4*)(bta + c + 4);
            const f32x4 o0 = (t0 - mean) * rstd * g0 + b0, o1 = (t1 - mean) * rstd * g1 + b1;
            *(f32x4*)(xr + c) = o0; *(f32x4*)(xr + c + 4) = o1;
            *(u32x4*)(xb + (size_t)row * DM + c) = pack8(o0, o1);
        }
    }
}

__device__ __forceinline__ void sgu_phase(LAS unsigned char* lds, const bf16_t* U, const bf16_t* GV, const bf16_t* SZ, const float* stats, const float* vg, const float* vb,
                                          const bf16_t* wsb, const float* b_s, bf16_t* Y, int G, int bid) {
    constexpr int VST = 272;
    LAS unsigned char* vnT = lds;
    LAS f32x2* rstat = (LAS f32x2*)(lds + 128 * VST);
    const int tid = threadIdx.x, wid = tid >> 6, lane = tid & 63, fr = lane & 15, fq = lane >> 4;
    const bool xmap = (G == 256);
    for (int itl = bid; itl < 1024; itl += G) {
        const int it = xmap ? ((bid & 7) * 128 + (bid >> 3) + 32 * (itl >> 8)) : itl;
        const int ci = it >> 4, g = it & 15, row0 = ci * 128;
        __syncthreads();
        if (tid < 128) {
            const float* sp = stats + (size_t)(row0 + tid) * 64; float s = 0.f, ss = 0.f;
#pragma unroll
            for (int i = 0; i < 16; ++i) { const f32x4 q = *(const f32x4*)(sp + i * 4); s += q[0] + q[2]; ss += q[1] + q[3]; }
            const float mean = s * (1.0f / DM), var = ss * (1.0f / DM) - mean * mean;
            rstat[tid] = (f32x2){mean, rsqrtf(var + 1e-5f)};
        }
        __syncthreads();
#pragma unroll
        for (int i = 0; i < 4; ++i) {
            const int id = tid + 512 * i, r = id >> 4, cc = id & 15;
            const u32x4 w = *(const u32x4*)(GV + (size_t)(row0 + r) * DM + g * 128 + cc * 8);
            const f32x2 st = rstat[r];
            const f32x4 g0 = *(const f32x4*)(vg + g * 128 + cc * 8), g1 = *(const f32x4*)(vg + g * 128 + cc * 8 + 4);
            const f32x4 b0 = *(const f32x4*)(vb + g * 128 + cc * 8), b1 = *(const f32x4*)(vb + g * 128 + cc * 8 + 4);
            float f[8] = {bf_lo(w.x), bf_hi(w.x), bf_lo(w.y), bf_hi(w.y), bf_lo(w.z), bf_hi(w.z), bf_lo(w.w), bf_hi(w.w)};
#pragma unroll
            for (int j = 0; j < 8; ++j) {
                const float gg = j < 4 ? g0[j & 3] : g1[j & 3], bb = j < 4 ? b0[j & 3] : b1[j & 3];
                const float vn = (f[j] - st.x) * st.y * gg + bb;
                *(LAS bf16_t*)(vnT + (cc * 8 + j) * VST + (((r >> 3) ^ cc) << 4) + (r & 7) * 2) = (bf16_t)(cvt_pk_bf16(vn, 0.f) & 0xffffu);
            }
        }
        __syncthreads();
        f32x4 acc[8];
#pragma unroll
        for (int ct = 0; ct < 8; ++ct) acc[ct] = (f32x4){0.f, 0.f, 0.f, 0.f};
        const bf16_t* wrow = wsb + ((size_t)g * 128 + wid * 16 + fr) * 128 + fq * 8;
        const int nks = (wid >> 1) + 1;
        for (int ks = 0; ks < nks; ++ks) {
            const bf16x8 wf = *(const bf16x8*)(wrow + ks * 32);
#pragma unroll
            for (int ct = 0; ct < 8; ++ct) {
                const bf16x8 vf = *(const LAS bf16x8*)(vnT + (ct * 16 + fr) * VST + (((ks * 4 + fq) ^ (ct * 2 + (fr >> 3))) << 4));
                acc[ct] = __builtin_amdgcn_mfma_f32_16x16x32_bf16(vf, wf, acc[ct], 0, 0, 0);
            }
        }
        const int t = wid * 16 + fr; const float bs = b_s[g * 128 + t];
        const size_t ro = (size_t)(row0 + t) * DM + g * 128 + 4 * fq;
#pragma unroll
        for (int ct = 0; ct < 8; ++ct) {
            const u32x2 uw = *(const u32x2*)(U + ro + ct * 16);
            const float y0 = bf_lo(uw.x) * (acc[ct][0] + bs), y1 = bf_hi(uw.x) * (acc[ct][1] + bs);
            const float y2 = bf_lo(uw.y) * (acc[ct][2] + bs), y3 = bf_hi(uw.y) * (acc[ct][3] + bs);
            u32x2 o; o.x = cvt_pk_bf16(y0, y1); o.y = cvt_pk_bf16(y2, y3);
            *(u32x2*)(Y + ro + ct * 16) = o;
        }
    }
    __syncthreads();
}

#define MFMA32(a, b, c) __builtin_amdgcn_mfma_f32_32x32x16_bf16((a), (b), (c), 0, 0, 0)
__device__ __forceinline__ void attn_phase(LAS unsigned char* lds, const bf16_t* Q, const bf16_t* Kb, const bf16_t* VT, const bf16_t* Z, const float* kpart, bf16_t* Y, int G, int bid) {
    constexpr int KST = 272, VSTR = 144, KBUF = 64 * KST, VBUF = 128 * VSTR;
    const int tid = threadIdx.x, wid = __builtin_amdgcn_readfirstlane(tid >> 6), lane = tid & 63, qr = lane & 31, hh = lane >> 5;
    const float NEG = -__builtin_inff();
    for (int pair = bid; pair < 256; pair += G) {
        const int bh = pair >> 2, jp = pair & 3, b = bh >> 4, h = bh & 15;
        for (int half = 0; half < 2; ++half) {
            const int own = half == 0 ? 7 - jp : jp;
            const int q0 = own * 256 + wid * 32;
            const size_t qoff = (size_t)(b * SEQ + q0 + qr) * DM + h * 128;
            bf16x8 Qf[8];
#pragma unroll
            for (int ks = 0; ks < 8; ++ks) Qf[ks] = *(const bf16x8*)(Q + qoff + ks * 16 + hh * 8);
            unsigned selmask = (1u << own) - 1u;
            if (own > 3) {
                f32x16 gacc;
#pragma unroll
                for (int j = 0; j < 16; ++j) gacc[j] = 0.f;
#pragma unroll
                for (int ks = 0; ks < 8; ++ks) {
                    u32x4 w = (u32x4){0u, 0u, 0u, 0u};
                    if (qr < 8) {
                        const float* kp = kpart + ((size_t)((b * 8 + qr) * 2)) * DM + h * 128 + ks * 16 + hh * 8;
                        const f32x4 a0 = *(const f32x4*)(kp), a1 = *(const f32x4*)(kp + 4), c0 = *(const f32x4*)(kp + DM), c1 = *(const f32x4*)(kp + DM + 4);
                        w = pack8((a0 + c0) * (1.0f / 256.0f), (a1 + c1) * (1.0f / 256.0f));
                    }
                    bf16x8 af; __builtin_memcpy(&af, &w, 16);
                    gacc = MFMA32(af, Qf[ks], gacc);
                }
                float gt[8];
#pragma unroll
                for (int j = 0; j < 4; ++j) { const float mine = gacc[j], oth = __shfl_xor(mine, 32); gt[j] = hh == 0 ? mine : oth; gt[4 + j] = hh == 0 ? oth : mine; }
#pragma unroll
                for (int j = 0; j < 8; ++j) if (j >= own) gt[j] = NEG;
                selmask = 0u;
#pragma unroll
                for (int r = 0; r < 3; ++r) {
                    float best = NEG; unsigned bi = 0u;
#pragma unroll
                    for (int j = 0; j < 8; ++j) { const bool take = !((selmask >> j) & 1u) && gt[j] > best; best = take ? gt[j] : best; bi = take ? (unsigned)j : bi; }
                    selmask |= 1u << bi;
                }
            }
            f32x16 O[4];
#pragma unroll
            for (int dt = 0; dt < 4; ++dt)
#pragma unroll
                for (int j = 0; j < 16; ++j) O[dt][j] = 0.f;
            float mrow = NEG, lsum = 0.f;
            const int ntile = (own + 1) * 4;
            const bf16_t* kg = Kb + (size_t)(b * SEQ) * DM + h * 128;
            const bf16_t* vg = VT + (size_t)((b * 16 + h) * 128) * SEQ;
            u32x4 kreg[2], vreg[2];
#define ATT_LOAD(i_) do { const int _i = (i_); const int _kt = _i < 4 ? own * 4 + _i : _i - 4; \
                _Pragma("unroll") for (int c2 = 0; c2 < 2; ++c2) { const int id = tid + 512 * c2; \
                    kreg[c2] = *(const u32x4*)(kg + (size_t)(_kt * 64 + (id >> 4)) * DM + (id & 15) * 8); \
                    vreg[c2] = *(const u32x4*)(vg + (size_t)(id >> 3) * SEQ + _kt * 64 + (id & 7) * 8); } } while (0)
#define ATT_STORE(buf_) do { _Pragma("unroll") for (int c2 = 0; c2 < 2; ++c2) { const int id = tid + 512 * c2; \
                    *(LAS u32x4*)(lds + (buf_) * KBUF + (id >> 4) * KST + (id & 15) * 16) = kreg[c2]; \
                    *(LAS u32x4*)(lds + 2 * KBUF + (buf_) * VBUF + (id >> 3) * VSTR + (id & 7) * 16) = vreg[c2]; } } while (0)
            ATT_LOAD(0);
            __syncthreads();
            ATT_STORE(0);
            ATT_LOAD(1);
            __syncthreads();
            for (int i = 0; i < ntile; ++i) {
                const int kt = i < 4 ? own * 4 + i : i - 4, buf = i & 1;
                const bool is_own = i < 4;
                const bool skip = is_own && (kt * 64 > q0 + 31);
                if (!skip) {
                    const LAS unsigned char* kb_ = lds + buf * KBUF;
                    const LAS unsigned char* vb_ = lds + 2 * KBUF + buf * VBUF;
                    f32x16 s0, s1;
                    const float sinit = (i == 0) ? 0.f : ((is_own || ((selmask >> (kt >> 2)) & 1u)) ? -mrow : -1.0e30f);
#pragma unroll
                    for (int j = 0; j < 16; ++j) { s0[j] = sinit; s1[j] = sinit; }
                    {
                        const LAS unsigned char* kp0 = kb_ + qr * KST + hh * 16; const LAS unsigned char* kp1 = kp0 + 32 * KST;
                        bf16x8 k0a = *(const LAS bf16x8*)(kp0), k0c = *(const LAS bf16x8*)(kp1);
                        bf16x8 k1a = *(const LAS bf16x8*)(kp0 + 32), k1c = *(const LAS bf16x8*)(kp1 + 32);
                        bf16x8 k2a = *(const LAS bf16x8*)(kp0 + 64), k2c = *(const LAS bf16x8*)(kp1 + 64);
#pragma unroll
                        for (int ks = 0; ks < 8; ++ks) {
                            bf16x8 na = k2a, nc = k2c;
                            if (ks < 5) { na = *(const LAS bf16x8*)(kp0 + (ks + 3) * 32); nc = *(const LAS bf16x8*)(kp1 + (ks + 3) * 32); }
                            __builtin_amdgcn_sched_barrier(0);
                            s0 = MFMA32(k0a, Qf[ks], s0); s1 = MFMA32(k0c, Qf[ks], s1);
                            __builtin_amdgcn_sched_barrier(0);
                            k0a = k1a; k0c = k1c; k1a = k2a; k1c = k2c; k2a = na; k2c = nc;
                        }
                    }
                    if (is_own) {
                        if (kt * 64 + 63 > q0) {
                            const int qpos = q0 + qr, kb0 = kt * 64 + hh * 4;
#pragma unroll
                            for (int j = 0; j < 16; ++j) { const int key = kb0 + (j >> 2) * 8 + (j & 3); if (key > qpos) s0[j] = NEG; if (key + 32 > qpos) s1[j] = NEG; }
                        }
                    }
                    if (i == 0) {
                        float mx = s0[0];
#pragma unroll
                        for (int j = 1; j < 16; ++j) mx = fmaxf(mx, s0[j]);
#pragma unroll
                        for (int j = 0; j < 16; ++j) mx = fmaxf(mx, s1[j]);
                        mx = fmaxf(mx, __shfl_xor(mx, 32));
                        mrow = mx;
#pragma unroll
                        for (int j = 0; j < 16; ++j) { s0[j] -= mx; s1[j] -= mx; }
                    }
                    float ps = 0.f;
#pragma unroll
                    for (int j = 0; j < 16; ++j) { s0[j] = __builtin_amdgcn_exp2f(s0[j]); s1[j] = __builtin_amdgcn_exp2f(s1[j]); ps += s0[j] + s1[j]; }
                    lsum += ps;
                    bf16x8 P[4];
                    { u32x4 w;
                      w.x = cvt_pk_bf16_t(s0[0], s0[1]); w.y = cvt_pk_bf16_t(s0[2], s0[3]); w.z = cvt_pk_bf16_t(s0[4], s0[5]); w.w = cvt_pk_bf16_t(s0[6], s0[7]); __builtin_memcpy(&P[0], &w, 16);
                      w.x = cvt_pk_bf16_t(s0[8], s0[9]); w.y = cvt_pk_bf16_t(s0[10], s0[11]); w.z = cvt_pk_bf16_t(s0[12], s0[13]); w.w = cvt_pk_bf16_t(s0[14], s0[15]); __builtin_memcpy(&P[1], &w, 16);
                      w.x = cvt_pk_bf16_t(s1[0], s1[1]); w.y = cvt_pk_bf16_t(s1[2], s1[3]); w.z = cvt_pk_bf16_t(s1[4], s1[5]); w.w = cvt_pk_bf16_t(s1[6], s1[7]); __builtin_memcpy(&P[2], &w, 16);
                      w.x = cvt_pk_bf16_t(s1[8], s1[9]); w.y = cvt_pk_bf16_t(s1[10], s1[11]); w.z = cvt_pk_bf16_t(s1[12], s1[13]); w.w = cvt_pk_bf16_t(s1[14], s1[15]); __builtin_memcpy(&P[3], &w, 16); }
                    {
                        const LAS unsigned char* vp = vb_ + qr * VSTR + hh * 16;
#define ATT_VADDR(st_, half_) (vp + (((st_) >> 2)) * 32 * VSTR + (((st_) & 3) + (half_)) * 32)
                        bf16x8 v0a = *(const LAS bf16x8*)ATT_VADDR(0, 0), v0c = *(const LAS bf16x8*)ATT_VADDR(0, 1);
                        bf16x8 v1a = *(const LAS bf16x8*)ATT_VADDR(2, 0), v1c = *(const LAS bf16x8*)ATT_VADDR(2, 1);
                        bf16x8 v2a = *(const LAS bf16x8*)ATT_VADDR(4, 0), v2c = *(const LAS bf16x8*)ATT_VADDR(4, 1);
#pragma unroll
                        for (int st = 0; st < 16; st += 2) {
                            const int dt = st >> 2, kk = st & 3;
                            bf16x8 na = v2a, nc = v2c;
                            if (st < 10) { na = *(const LAS bf16x8*)ATT_VADDR(st + 6, 0); nc = *(const LAS bf16x8*)ATT_VADDR(st + 6, 1); }
                            __builtin_amdgcn_sched_barrier(0);
                            O[dt] = MFMA32(v0a, P[kk], O[dt]); O[dt] = MFMA32(v0c, P[kk + 1], O[dt]);
                            __builtin_amdgcn_sched_barrier(0);
                            v0a = v1a; v0c = v1c; v1a = v2a; v1c = v2c; v2a = na; v2c = nc;
                        }
#undef ATT_VADDR
                    }
                }
                if (i + 1 < ntile) ATT_STORE((i + 1) & 1);
                asm volatile("s_waitcnt lgkmcnt(0)" ::: "memory"); __builtin_amdgcn_s_barrier(); asm volatile("" ::: "memory");
                if (i + 2 < ntile) ATT_LOAD(i + 2);
            }
#undef ATT_LOAD
#undef ATT_STORE
            const float ltot = lsum + __shfl_xor(lsum, 32), inv = 1.0f / ltot;
#pragma unroll
            for (int dt = 0; dt < 4; ++dt)
#pragma unroll
                for (int i4 = 0; i4 < 4; ++i4) {
                    const size_t o = qoff + dt * 32 + i4 * 8 + hh * 4;
                    const u32x2 zw = *(const u32x2*)(Z + o);
                    u32x2 ow;
                    ow.x = cvt_pk_bf16(O[dt][4 * i4 + 0] * inv * bf_lo(zw.x), O[dt][4 * i4 + 1] * inv * bf_hi(zw.x));
                    ow.y = cvt_pk_bf16(O[dt][4 * i4 + 2] * inv * bf_lo(zw.y), O[dt][4 * i4 + 3] * inv * bf_hi(zw.y));
                    *(u32x2*)(Y + o) = ow;
                }
        }
    }
    __syncthreads();
}


#define XB_TMO      128
#define XB_XCNT(j)  (256  + 64 * (j))
#define XB_XSUB(j)  (1280 + 64 * (j))
#define XB_XGEN(j)  (2304 + 64 * (j))
#define XB_TOP      3328
#define XB_TOPGEN   3392
#define XCD_BAR_WORDS 3456
#define XB_SPIN_CAP (1u << 18)
__device__ __forceinline__ unsigned xb_ld(unsigned* p)              { return __hip_atomic_load(p, __ATOMIC_RELAXED, __HIP_MEMORY_SCOPE_AGENT); }
__device__ __forceinline__ unsigned xb_add(unsigned* p, unsigned v) { return __hip_atomic_fetch_add(p, v, __ATOMIC_RELAXED, __HIP_MEMORY_SCOPE_AGENT); }
__device__ __forceinline__ unsigned xb_xcc_id() { return (unsigned)__builtin_amdgcn_s_getreg((3 << 11) | 20) & 0xFu; }
#define XB_SPIN(cond, bar) do { unsigned _sp = 0; while (cond) { __builtin_amdgcn_s_sleep(1); \
    if ((++_sp & 255u) == 0u) { if (xb_ld(&(bar)[XB_TMO])) break; if (_sp > XB_SPIN_CAP) { atomicAdd(&(bar)[XB_TMO], 1u); break; } } } } while (0)
struct XcdBarrier { unsigned* bar; unsigned x; volatile LAS unsigned* st; };
__device__ __forceinline__ XcdBarrier xcd_barrier_post(unsigned* bar, volatile LAS unsigned* st) {
    XcdBarrier b; b.bar = bar; b.x = xb_xcc_id(); b.st = st;
    if (threadIdx.x == 0) (void)xb_add(&bar[XB_XCNT(b.x)], 1u);
    return b;
}
__device__ __forceinline__ void xcd_barrier_complete(unsigned* bar, unsigned x, unsigned& nloc, unsigned& nx) {
    const unsigned G = gridDim.x * gridDim.y * gridDim.z;
    unsigned sum, cnt, mine, sp = 0u;
    for (;;) {
        sum = 0u; cnt = 0u; mine = 0u;
#pragma unroll
        for (unsigned j = 0; j < 16; ++j) { const unsigned c = xb_ld(&bar[XB_XCNT(j)]); sum += c; cnt += (c > 0u) ? 1u : 0u; mine = (j == x) ? c : mine; }
        if (sum == G) break;
        __builtin_amdgcn_s_sleep(1);
        if ((++sp & 255u) == 0u) { if (xb_ld(&bar[XB_TMO])) break; if (sp > XB_SPIN_CAP) { atomicAdd(&bar[XB_TMO], 1u); break; } }
    }
    nloc = mine > 0u ? mine : 1u; nx = cnt > 0u ? cnt : 1u;
}
__device__ __forceinline__ void xcd_barrier(const XcdBarrier& b) {
    asm volatile("s_waitcnt vmcnt(0)" ::: "memory");
    __syncthreads();
    if (threadIdx.x == 0) {
        unsigned* bar = b.bar;
        __builtin_amdgcn_s_waitcnt(0);
        unsigned nloc = b.st[0], nx = b.st[1];
        if (nloc == 0u) { xcd_barrier_complete(bar, b.x, nloc, nx); b.st[0] = nloc; b.st[1] = nx; }
        const unsigned old = xb_add(&bar[XB_XSUB(b.x)], 1u);
        const unsigned gen = old / nloc;
        if (old + 1u == (gen + 1u) * nloc) {
            __builtin_amdgcn_fence(__ATOMIC_RELEASE, "agent");
            asm volatile("s_waitcnt vmcnt(0)" ::: "memory");
            const unsigned og = xb_add(&bar[XB_TOP], 1u);
            const unsigned tg = og / nx;
            if (og + 1u == (tg + 1u) * nx) xb_add(&bar[XB_TOPGEN], 1u);
            else XB_SPIN(xb_ld(&bar[XB_TOPGEN]) == tg, bar);
            __builtin_amdgcn_fence(__ATOMIC_ACQUIRE, "agent");
            xb_add(&bar[XB_XGEN(b.x)], 1u);
            asm volatile("s_waitcnt vmcnt(0)" ::: "memory");
        } else {
            XB_SPIN(xb_ld(&bar[XB_XGEN(b.x)]) == gen, bar);
            __builtin_amdgcn_fence(__ATOMIC_ACQUIRE, "agent");
            asm volatile("s_waitcnt vmcnt(0)" ::: "memory");
        }
    }
    __syncthreads();
}

constexpr int NPHASE = 11;
__global__ void __launch_bounds__(NTHREADS, 2) mk_fwd(Params P) {
    extern __shared__ __attribute__((aligned(16))) unsigned char lds_raw[];
    LAS unsigned char* lds = (LAS unsigned char*)lds_raw;
    cg::grid_group grid = cg::this_grid();
    const int G = gridDim.x, bid = blockIdx.x, lo = P.lo, hi = P.hi;
    unsigned char* ws = P.ws;
    bf16_t* WINB = (bf16_t*)(ws + WS_WINB); bf16_t* WOUT1 = (bf16_t*)(ws + WS_WOUT1); bf16_t* WG1 = (bf16_t*)(ws + WS_WG1); bf16_t* WP = (bf16_t*)(ws + WS_WP);
    bf16_t* PB = (bf16_t*)(ws + WS_PB); float* STATS = (float*)(ws + WS_STATS); float* KPART = (float*)(ws + WS_KPART); bf16_t* WSB = (bf16_t*)(ws + WS_WSB);
    bf16_t* SLOTA = (bf16_t*)(ws + WS_SLOTA); bf16_t* WINA = (bf16_t*)(ws + WS_WINA); bf16_t* WOUT0 = (bf16_t*)(ws + WS_WOUT0); bf16_t* WG0 = (bf16_t*)(ws + WS_WG0);
    bf16_t* Ub = (bf16_t*)(ws + WS_U); bf16_t* GVb = (bf16_t*)(ws + WS_GV); bf16_t* SZb = (bf16_t*)(ws + WS_SZ);
    bf16_t* Qb = (bf16_t*)(ws + WS_Q); bf16_t* Kb = (bf16_t*)(ws + WS_K); bf16_t* VTb = (bf16_t*)(ws + WS_VT); bf16_t* Zb = (bf16_t*)(ws + WS_Z);
    bf16_t* PP0 = (bf16_t*)(ws + WS_PP0); bf16_t* PP1 = (bf16_t*)(ws + WS_PP1); bf16_t* X1B = (bf16_t*)(ws + WS_X1B); bf16_t* X3B = (bf16_t*)(ws + WS_X3B); bf16_t* Y1 = (bf16_t*)P.out;
    const float ALPHA = 1.4142135623730951f;
#define IN(k) (lo <= (k) && (k) < hi)
    volatile LAS unsigned* xst = (volatile LAS unsigned*)(lds + LDS_MAIN);
    if (threadIdx.x == 0) { xst[0] = 0u; xst[1] = 0u; }
    __syncthreads();
    XcdBarrier xbar; xbar.bar = (unsigned*)(ws + WS_BAR); xbar.x = 0; xbar.st = xst;
    if (hi - lo > 1) xbar = xcd_barrier_post((unsigned*)(ws + WS_BAR), xst);
    if (hi > NPHASE) grid.sync();
#define SEAM(k) do { if (IN(k) && hi > (k) + 1) xcd_barrier(xbar); } while (0)

    if (IN(0)) {
        transpose_convert(lds, P.w_in_b, WINB, 2048, 8192, G, bid);
        transpose_convert(lds, P.w_out, WOUT0, 2048, 2048, G, bid);
        transpose_convert(lds, P.w_out + (size_t)2048 * 2048, WOUT1, 2048, 2048, G, bid);
        transpose_convert(lds, P.w_gate, WG0, 2048, 2048, G, bid);
        transpose_convert(lds, P.w_gate + (size_t)2048 * 2048, WG1, 2048, 2048, G, bid);
        transpose_convert(lds, P.w_proj, WP, 256, 2048, G, bid);
        transpose_convert(lds, P.w_proj + (size_t)256 * 2048, WP + (size_t)2048 * 256, 256, 2048, G, bid);
        convert_flat(P.p, PB, (size_t)2 * MTOK * 256, G, bid);
        for (int i = bid * NTHREADS + threadIdx.x; i < 16 * 128 * 128; i += G * NTHREADS) { const int s = i & 127, t = (i >> 7) & 127; WSB[i] = (bf16_t)(cvt_pk_bf16(s <= t ? P.w_s[i] : 0.f, 0.f) & 0xffffu); }
        transpose_convert<true>(lds, P.w_in_a, WINA, 2048, 6144, G, bid);
        if (G == 256) convert_rows_xcd(P.x, SLOTA, G, bid); else convert_flat(P.x, SLOTA, (size_t)MTOK * DM, G, bid);
    }
    SEAM(0);
    if (IN(1)) {
        pg8::Gemm g{SLOTA, WINA, MTOK, 6144, 2048, 1 << 30, 0}; pg8::StaticOrder S; S.init(MTOK, 6144, G, bid);
        EpiL0In E{Ub, GVb, STATS};
        pg8::gemm_phase<EpiL0In, true>(lds, g, S, E);
    }
    SEAM(1);
    if (IN(2)) sgu_phase(lds, Ub, GVb, SZb, STATS, P.sgu_g, P.sgu_b, WSB, P.b_s, Y1, G, bid);
    SEAM(2);
    if (IN(3)) {
        { pg8::Gemm g{PB, WP, 2 * MTOK, 2048, 256, 32, 8}; pg8::StaticOrder S; S.init(2 * MTOK, 2048, G, bid);
          EpiPlain E{PP0, (long long)((WS_PP1 - WS_PP0) / 2)}; pg8::gemm_phase(lds, g, S, E); }
        { pg8::Gemm g{Y1, WOUT0, MTOK, 2048, 2048, 1 << 30, 0}; pg8::StaticOrder S; S.init(MTOK, 2048, G, bid);
          EpiResLn<true> E{SLOTA, X1B, P.ln_g, P.ln_b, ws, 0, 0}; pg8::gemm_phase(lds, g, S, E); }
    }
    SEAM(3);
    if (IN(5)) {
        pg8::Gemm g{X1B, WG0, MTOK, 2048, 2048, 1 << 30, 0}; pg8::StaticOrder S; S.init(MTOK, 2048, G, bid);
        EpiPle<false> E{X1B, PP0, SLOTA, nullptr}; pg8::gemm_phase<EpiPle<false>, true>(lds, g, S, E);
    }
    SEAM(5);
    if (IN(6)) {
        pg8::Gemm g{SLOTA, WINB, MTOK, 8192, 2048, 1 << 30, 0}; pg8::StaticOrder S; S.init(MTOK, 8192, G, bid);
        EpiL1In E{Qb, Kb, VTb, Zb, KPART}; pg8::gemm_phase<EpiL1In, true>(lds, g, S, E);
    }
    SEAM(6);
    if (IN(7)) attn_phase(lds, Qb, Kb, VTb, Zb, KPART, Y1, G, bid);
    SEAM(7);
    if (IN(8)) {
        { pg8::Gemm g{Y1, WOUT1, MTOK, 2048, 2048, 1 << 30, 0}; pg8::StaticOrder S; S.init(MTOK, 2048, G, bid);
          EpiResLn<true> E{SLOTA, X3B, P.ln_g + DM, P.ln_b + DM, ws, 1, 0}; pg8::gemm_phase(lds, g, S, E); }
    }
    SEAM(8);
    if (IN(10)) {
        pg8::Gemm g{X3B, WG1, MTOK, 2048, 2048, 1 << 30, 0}; pg8::StaticOrder S; S.init(MTOK, 2048, G, bid);
        EpiPle<true> E{X3B, PP1, nullptr, P.out}; pg8::gemm_phase<EpiPle<true>, true>(lds, g, S, E);
    }
#undef IN
#undef SEAM
}

extern "C" void kernel_launch(void* const* d_in, const int* in_sizes, int n_in, void* d_out, int out_size, void* d_ws, size_t ws_size, hipStream_t stream) {
    static int grid_blocks = 0;
    if (grid_blocks == 0) {
        if (n_in != 13 || out_size != MTOK * DM || ws_size < WS_END) { fprintf(stderr, "kernel_launch: unexpected shapes (n_in %d out %d ws %zu)\n", n_in, out_size, ws_size); grid_blocks = -1; return; }
        int dev = 0, cus = 0, per_cu = 0;
        hipGetDevice(&dev);
        hipDeviceGetAttribute(&cus, hipDeviceAttributeMultiprocessorCount, dev);
        if (hipFuncSetAttribute((const void*)mk_fwd, hipFuncAttributeMaxDynamicSharedMemorySize, LDS_BYTES) != hipSuccess) { fprintf(stderr, "kernel_launch: hipFuncSetAttribute failed\n"); grid_blocks = -1; return; }
        if (hipOccupancyMaxActiveBlocksPerMultiprocessor(&per_cu, (const void*)mk_fwd, NTHREADS, LDS_BYTES) != hipSuccess || per_cu < 1) { fprintf(stderr, "kernel_launch: occupancy query failed (%d)\n", per_cu); grid_blocks = -1; return; }
        grid_blocks = cus;
    }
    if (grid_blocks < 0) return;
    if (hipMemsetAsync((unsigned char*)d_ws + WS_BAR, 0, 16384 + 32768, stream) != hipSuccess) { fprintf(stderr, "kernel_launch: memset of the barrier words failed\n"); return; }
    Params p{};
    p.x = (const float*)d_in[0]; p.p = (const float*)d_in[1]; p.w_in_a = (const float*)d_in[2]; p.sgu_g = (const float*)d_in[3]; p.sgu_b = (const float*)d_in[4];
    p.w_s = (const float*)d_in[5]; p.b_s = (const float*)d_in[6]; p.w_in_b = (const float*)d_in[7]; p.w_out = (const float*)d_in[8]; p.ln_g = (const float*)d_in[9];
    p.ln_b = (const float*)d_in[10]; p.w_gate = (const float*)d_in[11]; p.w_proj = (const float*)d_in[12];
    p.out = (float*)d_out; p.ws = (unsigned char*)d_ws;
#if ONE_LAUNCH
    p.lo = 0; p.hi = NPHASE;
    void* args[] = {&p};
    hipError_t e = hipLaunchCooperativeKernel((const void*)mk_fwd, dim3(grid_blocks), dim3(NTHREADS), args, LDS_BYTES, stream);
    if (e != hipSuccess) fprintf(stderr, "cooperative launch failed: %s (grid %d)\n", hipGetErrorString(e), grid_blocks);
#else
    for (int k = 0; k < NPHASE; ++k) {
        p.lo = k; p.hi = k + 1;
        hipLaunchKernelGGL(mk_fwd, dim3(grid_blocks), dim3(NTHREADS), LDS_BYTES, stream, p);
    }
#endif
}
```

```cpp
#include <hip/hip_runtime.h>
#include <hip/hip_cooperative_groups.h>
#include <cstdio>
namespace cg = cooperative_groups;

#ifndef ONE_LAUNCH
#define ONE_LAUNCH 1
#endif

#define LAS __attribute__((address_space(3)))
typedef unsigned short bf16_t;
typedef short bf16x8 __attribute__((ext_vector_type(8)));
typedef float f32x4 __attribute__((ext_vector_type(4)));
typedef float f32x2 __attribute__((ext_vector_type(2)));
typedef float f32x16 __attribute__((ext_vector_type(16)));
typedef unsigned u32x4 __attribute__((ext_vector_type(4)));
typedef unsigned u32x2 __attribute__((ext_vector_type(2)));

constexpr int MTOK = 8192, DM = 2048, SEQ = 2048;
constexpr int NTHREADS = 512;
constexpr int LDS_MAIN = 131072, LDS_BYTES = LDS_MAIN + 16;
constexpr size_t TT = 33554432ull;
constexpr size_t WS_WINB = 0, WS_WOUT1 = TT, WS_WG1 = TT + TT / 4, WS_WP = TT + TT / 2, WS_PB = WS_WP + TT / 16, WS_MISC = WS_PB + TT / 4;
constexpr size_t WS_STATS = WS_MISC, WS_KPART = WS_MISC + (2u << 20), WS_WSB = WS_KPART + (512u << 10), WS_BAR = WS_WSB + (512u << 10), WS_CNT = WS_BAR + 16384, WS_SLOTS = WS_CNT + 32768;
constexpr size_t WS_SLOTA = 2 * TT, WS_WINA = 3 * TT, WS_WOUT0 = 3 * TT + 3 * (TT / 4), WS_WG0 = 4 * TT, WS_U = 4 * TT + TT / 4, WS_GV = WS_U + TT, WS_SZ = WS_GV + TT;
constexpr size_t WS_Q = 3 * TT, WS_K = 4 * TT, WS_VT = 5 * TT, WS_Z = 6 * TT, WS_PP1 = 7 * TT, WS_X3B = 4 * TT, WS_PP0 = WS_U, WS_X1B = WS_GV;
constexpr size_t WS_END = 8 * TT;
static_assert(WS_SZ + TT <= WS_END && WS_WSB + (512u << 10) <= WS_SLOTA && WS_GV == WS_U + TT && WS_SZ == WS_U + 2 * TT && WS_K == WS_Q + TT && WS_VT == WS_Q + 2 * TT && WS_Z == WS_Q + 3 * TT, "workspace map");

struct Params {
    const float* x; const float* p; const float* w_in_a; const float* sgu_g; const float* sgu_b; const float* w_s; const float* b_s; const float* w_in_b;
    const float* w_out; const float* ln_g; const float* ln_b; const float* w_gate; const float* w_proj;
    float* out; unsigned char* ws; int lo, hi;
};

__device__ __forceinline__ unsigned cvt_pk_bf16(float lo, float hi) { unsigned r; asm volatile("v_cvt_pk_bf16_f32 %0, %1, %2" : "=v"(r) : "v"(lo), "v"(hi)); return r; }
__device__ __forceinline__ unsigned cvt_pk_bf16_t(float lo, float hi) { unsigned r; asm volatile("s_nop 1\n\tv_cvt_pk_bf16_f32 %0, %1, %2" : "=v"(r) : "v"(lo), "v"(hi)); return r; }
__device__ __forceinline__ float bf_lo(unsigned w) { return __uint_as_float(w << 16); }
__device__ __forceinline__ float bf_hi(unsigned w) { return __uint_as_float(w & 0xffff0000u); }
__device__ __forceinline__ float fast_sigmoid(float v) { return __builtin_amdgcn_rcpf(1.0f + __builtin_amdgcn_exp2f(-1.4426950408889634f * v)); }
__device__ __forceinline__ float silu_f(float v) { return v * fast_sigmoid(v); }
__device__ __forceinline__ float gelu_f(float v) { const float u = 1.5957691216057308f * (v + 0.044715f * v * v * v); return v * fast_sigmoid(u); }

namespace pg8 {
constexpr int BM = 256, BK = 64, HALF = 128, HTB = HALF * BK * 2, STAGE_BYTES = 8 * HTB, NXCD = 8, WGM = 4;
__host__ __device__ __forceinline__ int lds_byte(int r, int c) { const int st = (r >> 4) * 2 + (c >> 5), rr = r & 15, cc = c & 31, ob = rr * 64 + cc * 2; return st * 1024 + (ob ^ (((ob >> 9) & 1) << 5)); }
__host__ __device__ __forceinline__ void stage_rc(int b, int& R, int& C) { const int st = b / 1024, sb = b % 1024, swz = sb ^ (((sb >> 9) & 1) << 5); R = (st >> 1) * 16 + swz / 64; C = (st & 1) * 32 + (swz % 64) / 2; }
__host__ __device__ __forceinline__ int perm32(int rho) { const int n = rho >> 4, i = rho & 15; return 8 * (i >> 2) + 4 * n + (i & 3); }
struct Unit { int pm, pn; };
struct Gemm { const bf16_t* A; const bf16_t* Bt; int M, N, K; int bsplit, badd; };
struct StaticOrder {
    int nM, nN, nwg, G, c;
    __device__ void init(int M, int N, int G_, int c_) { nM = M / BM; nN = N / BM; nwg = nM * nN; G = G_; c = c_; }
    __device__ bool next(int i, Unit& u) const {
        const long L = (long)i * G + c; if (L >= nwg) return false;
        int wgid = (int)L; { const int q = nwg / NXCD, r = nwg % NXCD, xcd = wgid % NXCD, off = wgid / NXCD; wgid = (xcd < r ? xcd * (q + 1) : r * (q + 1) + (xcd - r) * q) + off; }
        const int nig = WGM * nN, gid = wgid / nig, fm = gid * WGM, gsz = (nM - fm) < WGM ? (nM - fm) : WGM;
        u.pm = fm + ((wgid % nig) % gsz); u.pn = (wgid % nig) / gsz; return true;
    }
};
template <class Epi, bool ALIGN_EPI = false, bool SP2 = true>
__device__ __forceinline__ void gemm_phase(LAS unsigned char* lds, const Gemm g, const StaticOrder& S, const Epi& E) {
    const int tid = threadIdx.x, wid = __builtin_amdgcn_readfirstlane(tid >> 6), lane = tid & 63, wr = wid >> 2, wc = wid & 3, fr = lane & 15, fq = lane >> 4;
    const int K = g.K, nt = K / BK;
    unsigned voffA[2], voffB[2];
#pragma unroll
    for (int i = 0; i < 2; ++i) { int R, C; stage_rc(tid * 16 + i * 8192, R, C); const int Rb = (R & ~31) + perm32(R & 31);
        voffA[i] = (unsigned)(R * K + C) * 2u; voffB[i] = (unsigned)(Rb * K + C) * 2u; }
    const size_t kstep = (size_t)(BK * 2);
    const size_t hstep = (size_t)HALF * K * 2;
    const size_t tstep = 2 * hstep;
    const unsigned ldsw = (unsigned)wid * 1024u;
    const int aoff = lds_byte(wr * 64 + fr, fq * 8), boff = lds_byte(wc * 32 + fr, fq * 8);
#define PG8_SA(b, h) (((b) * 2 + (h)) * HTB)
#define PG8_SB(b, h) ((4 + (b) * 2 + (h)) * HTB)
#define PG8_STAGE(bufoff, gbase, voff) do { _Pragma("unroll") for (int _i = 0; _i < 2; ++_i) \
        __builtin_amdgcn_global_load_lds((const unsigned*)((const char*)(gbase) + (voff)[_i]), (LAS unsigned*)(lds + (bufoff) + ldsw + _i * 8192), 16, 0, 0); } while (0)
#define PG8_LDA(dst, b, h) do { _Pragma("unroll") for (int m = 0; m < 4; ++m) _Pragma("unroll") for (int k = 0; k < 2; ++k) dst[m][k] = *(const LAS bf16x8*)(lds + PG8_SA(b, h) + aoff + m * 2048 + k * 1024); } while (0)
#define PG8_LDB(dst, b, h) do { _Pragma("unroll") for (int n = 0; n < 2; ++n) _Pragma("unroll") for (int k = 0; k < 2; ++k) dst[n][k] = *(const LAS bf16x8*)(lds + PG8_SB(b, h) + boff + n * 2048 + k * 1024); } while (0)
#define PG8_MMA(ai, bj, At, Bt) do { __builtin_amdgcn_s_setprio(1); _Pragma("unroll") for (int m = 0; m < 4; ++m) _Pragma("unroll") for (int n = 0; n < 2; ++n) _Pragma("unroll") for (int k = 0; k < 2; ++k) \
        acc[ai][bj][m][n] = __builtin_amdgcn_mfma_f32_16x16x32_bf16(Bt[n][k], At[m][k], acc[ai][bj][m][n], 0, 0, 0); __builtin_amdgcn_s_setprio(0); } while (0)
#define PG8_WAIT_V(n) asm volatile("s_waitcnt vmcnt(" #n ")" ::: "memory")
#define PG8_WAIT_L(n) asm volatile("s_waitcnt lgkmcnt(" #n ")" ::: "memory")
#define PG8_BAR __builtin_amdgcn_s_barrier()
#define PG8_SCHED __builtin_amdgcn_sched_barrier(0)
    Unit cur, nxt; int ui = 0;
    if (!S.next(0, cur)) return;
    f32x4 acc[2][2][4][2];
#pragma unroll
    for (int a = 0; a < 2; ++a)
#pragma unroll
        for (int b = 0; b < 2; ++b)
#pragma unroll
            for (int m = 0; m < 4; ++m)
#pragma unroll
                for (int n = 0; n < 2; ++n) acc[a][b][m][n] = (f32x4){0.f, 0.f, 0.f, 0.f};
    bf16x8 At[4][2], B0[2][2], B1[2][2];
    const char* cA = (const char*)g.A + (size_t)cur.pm * tstep; const char* cB = (const char*)g.Bt + (size_t)(cur.pn + (cur.pm >= g.bsplit ? g.badd : 0)) * tstep;
    if constexpr (SP2) {
        PG8_STAGE(PG8_SB(0, 0), cB, voffB); PG8_STAGE(PG8_SB(0, 1), cB + hstep, voffB); PG8_STAGE(PG8_SA(0, 0), cA, voffA); PG8_STAGE(PG8_SA(0, 1), cA + hstep, voffA);
        if (wr == 1) PG8_BAR;
        PG8_WAIT_V(2); PG8_BAR;
        PG8_STAGE(PG8_SB(1, 0), cB + kstep, voffB); PG8_STAGE(PG8_SA(1, 0), cA + kstep, voffA); PG8_STAGE(PG8_SB(1, 1), cB + hstep + kstep, voffB);
        PG8_WAIT_V(6); PG8_BAR;
    } else {
        PG8_STAGE(PG8_SB(0, 0), cB, voffB); PG8_STAGE(PG8_SA(0, 0), cA, voffA); PG8_STAGE(PG8_SB(0, 1), cB + hstep, voffB); PG8_STAGE(PG8_SA(0, 1), cA + hstep, voffA);
        if (wr == 1) PG8_BAR;
        PG8_WAIT_V(4); PG8_BAR;
        PG8_STAGE(PG8_SB(1, 0), cB + kstep, voffB); PG8_STAGE(PG8_SA(1, 0), cA + kstep, voffA); PG8_STAGE(PG8_SB(1, 1), cB + hstep + kstep, voffB);
        PG8_WAIT_V(6); PG8_BAR;
    }
    for (;;) {
        const bool has_next = S.next(ui + 1, nxt);
        const char* nA = has_next ? (const char*)g.A + (size_t)nxt.pm * tstep : cA; const char* nB = has_next ? (const char*)g.Bt + (size_t)(nxt.pn + (nxt.pm >= g.bsplit ? g.badd : 0)) * tstep : cB;
        for (int t = 0; t < nt; t += 2) {
            const bool last = (t == nt - 2);
            const char* a1 = cA + (size_t)(t + 1) * kstep;
            const char* a2 = last ? nA : cA + (size_t)(t + 2) * kstep; const char* b2 = last ? nB : cB + (size_t)(t + 2) * kstep;
            const char* a3 = a2 + kstep; const char* b3 = b2 + kstep;
            if constexpr (SP2) {
            PG8_LDB(B0, 0, 0); PG8_LDB(B1, 0, 1); PG8_SCHED; PG8_LDA(At, 0, 0); PG8_STAGE(PG8_SA(1, 1), a1 + hstep, voffA);
            PG8_WAIT_V(8); PG8_WAIT_L(0); PG8_BAR; PG8_MMA(0, 0, At, B0); PG8_MMA(0, 1, At, B1); PG8_BAR; PG8_SCHED;
            PG8_LDA(At, 0, 1); PG8_STAGE(PG8_SB(0, 0), b2, voffB); PG8_STAGE(PG8_SB(0, 1), b2 + hstep, voffB); PG8_STAGE(PG8_SA(0, 0), a2, voffA);
            PG8_WAIT_V(8); PG8_WAIT_L(0); PG8_BAR; PG8_MMA(1, 0, At, B0); PG8_MMA(1, 1, At, B1); PG8_BAR; PG8_SCHED;
            PG8_LDB(B0, 1, 0); PG8_LDB(B1, 1, 1); PG8_SCHED; PG8_LDA(At, 1, 0); PG8_STAGE(PG8_SA(0, 1), a2 + hstep, voffA);
            PG8_WAIT_V(8); PG8_WAIT_L(0); PG8_BAR; PG8_MMA(0, 0, At, B0); PG8_MMA(0, 1, At, B1); PG8_BAR; PG8_SCHED;
            PG8_LDA(At, 1, 1); PG8_STAGE(PG8_SB(1, 0), b3, voffB); PG8_STAGE(PG8_SB(1, 1), b3 + hstep, voffB); PG8_STAGE(PG8_SA(1, 0), a3, voffA);
            PG8_WAIT_V(8); PG8_WAIT_L(0); PG8_BAR; PG8_MMA(1, 0, At, B0); PG8_MMA(1, 1, At, B1); PG8_BAR; PG8_SCHED;
            } else {
            PG8_LDB(B0, 0, 0); PG8_SCHED; PG8_LDA(At, 0, 0); PG8_STAGE(PG8_SA(1, 1), a1 + hstep, voffA);
            PG8_WAIT_L(8); PG8_BAR; PG8_WAIT_L(0); PG8_MMA(0, 0, At, B0); PG8_BAR; PG8_SCHED;
            PG8_LDB(B1, 0, 1); PG8_STAGE(PG8_SB(0, 0), b2, voffB);
            PG8_BAR; PG8_WAIT_L(0); PG8_MMA(0, 1, At, B1); PG8_BAR;
            PG8_LDA(At, 0, 1); PG8_STAGE(PG8_SA(0, 0), a2, voffA);
            PG8_BAR; PG8_WAIT_L(0); PG8_MMA(1, 0, At, B0); PG8_BAR; PG8_SCHED;
            PG8_STAGE(PG8_SB(0, 1), b2 + hstep, voffB);
            PG8_WAIT_V(6); PG8_BAR; PG8_MMA(1, 1, At, B1); PG8_BAR;
            PG8_LDB(B0, 1, 0); PG8_SCHED; PG8_LDA(At, 1, 0); PG8_STAGE(PG8_SA(0, 1), a2 + hstep, voffA);
            PG8_WAIT_L(8); PG8_BAR; PG8_WAIT_L(0); PG8_MMA(0, 0, At, B0); PG8_BAR; PG8_SCHED;
            PG8_LDB(B1, 1, 1); PG8_STAGE(PG8_SB(1, 0), b3, voffB);
            PG8_BAR; PG8_WAIT_L(0); PG8_MMA(0, 1, At, B1); PG8_BAR;
            PG8_LDA(At, 1, 1); PG8_STAGE(PG8_SA(1, 0), a3, voffA);
            PG8_BAR; PG8_WAIT_L(0); PG8_MMA(1, 0, At, B0); PG8_BAR; PG8_SCHED;
            PG8_STAGE(PG8_SB(1, 1), b3 + hstep, voffB);
            PG8_WAIT_V(6); PG8_BAR; PG8_MMA(1, 1, At, B1); PG8_BAR;
            }
        }
        if constexpr (ALIGN_EPI) { if (wr == 0) PG8_BAR; }
        if constexpr (!Epi::AFTER_DRAIN) E(acc, cur, wr, wc, fr, fq);
        if (!has_next) break;
#pragma unroll
        for (int a = 0; a < 2; ++a)
#pragma unroll
            for (int b = 0; b < 2; ++b)
#pragma unroll
                for (int m = 0; m < 4; ++m)
#pragma unroll
                    for (int n = 0; n < 2; ++n) acc[a][b][m][n] = (f32x4){0.f, 0.f, 0.f, 0.f};
        cur = nxt; cA = nA; cB = nB; ++ui;
        if constexpr (ALIGN_EPI) { if (wr == 1) PG8_BAR; }
    }
    PG8_WAIT_V(0);
    if constexpr (!ALIGN_EPI) { if (wr == 0) PG8_BAR; }
    PG8_BAR;
    if constexpr (Epi::AFTER_DRAIN) E.fused(acc, cur, wr, wc, fr, fq, lds, wid, lane);
#undef PG8_SA
#undef PG8_SB
#undef PG8_STAGE
#undef PG8_LDA
#undef PG8_LDB
#undef PG8_MMA
#undef PG8_WAIT_V
#undef PG8_WAIT_L
#undef PG8_BAR
#undef PG8_SCHED
}
}
using pg8::Unit;
typedef f32x4 Acc[2][2][4][2];

__device__ __forceinline__ u32x4 pack8(const f32x4 a, const f32x4 b) { u32x4 w; w.x = cvt_pk_bf16(a[0], a[1]); w.y = cvt_pk_bf16(a[2], a[3]); w.z = cvt_pk_bf16(b[0], b[1]); w.w = cvt_pk_bf16(b[2], b[3]); return w; }

struct EpiL0In {
    static constexpr bool AFTER_DRAIN = false;
    bf16_t* UZ; bf16_t* GV; float* stats;
    __device__ __forceinline__ void operator()(const Acc& acc, const Unit& u, int wr, int wc, int fr, int fq) const {
        if (u.pn < 16) {
            const int cb = u.pn * 128 + wc * 32 + 8 * fq;
#pragma unroll
            for (int ai = 0; ai < 2; ++ai)
#pragma unroll
                for (int m = 0; m < 4; ++m) {
                    const int row = u.pm * 256 + ai * 128 + wr * 64 + m * 16 + fr;
                    f32x4 a0 = acc[ai][0][m][0], a1 = acc[ai][0][m][1]; const f32x4 z0 = acc[ai][1][m][0], z1 = acc[ai][1][m][1];
#pragma unroll
                    for (int j = 0; j < 4; ++j) { a0[j] = gelu_f(a0[j]) * silu_f(z0[j]); a1[j] = gelu_f(a1[j]) * silu_f(z1[j]); }
                    *(u32x4*)(UZ + (size_t)row * DM + cb) = pack8(a0, a1);
                }
        } else {
            const int pnv = u.pn - 16, cb = pnv * 256 + wc * 32 + 8 * fq;
#pragma unroll
            for (int ai = 0; ai < 2; ++ai)
#pragma unroll
                for (int m = 0; m < 4; ++m) {
                    const int row = u.pm * 256 + ai * 128 + wr * 64 + m * 16 + fr;
                    float s = 0.f, ss = 0.f;
#pragma unroll
                    for (int bj = 0; bj < 2; ++bj) {
                        f32x4 v0 = acc[ai][bj][m][0], v1 = acc[ai][bj][m][1];
#pragma unroll
                        for (int j = 0; j < 4; ++j) { v0[j] = gelu_f(v0[j]); v1[j] = gelu_f(v1[j]); }
#pragma unroll
                        for (int j = 0; j < 4; ++j) { s += v0[j] + v1[j]; ss += v0[j] * v0[j] + v1[j] * v1[j]; }
                        *(u32x4*)(GV + (size_t)row * DM + cb + bj * 128) = pack8(v0, v1);
                    }
                    s += __shfl_xor(s, 16); s += __shfl_xor(s, 32); ss += __shfl_xor(ss, 16); ss += __shfl_xor(ss, 32);
                    if (fq == 0) *(f32x2*)(stats + ((size_t)row * 32 + pnv * 4 + wc) * 2) = (f32x2){s, ss};
                }
        }
    }
};
struct EpiPlain {
    static constexpr bool AFTER_DRAIN = false;
    bf16_t* O; long long delta2;
    __device__ __forceinline__ void operator()(const Acc& acc, const Unit& u, int wr, int wc, int fr, int fq) const {
        const int cb = u.pn * 256 + wc * 32 + 8 * fq;
        bf16_t* Ob = O + (u.pm >= 32 ? delta2 - (long long)32 * 256 * DM : 0ll);
#pragma unroll
        for (int ai = 0; ai < 2; ++ai)
#pragma unroll
            for (int m = 0; m < 4; ++m) {
                const int row = u.pm * 256 + ai * 128 + wr * 64 + m * 16 + fr;
#pragma unroll
                for (int bj = 0; bj < 2; ++bj) *(u32x4*)(Ob + (size_t)row * DM + cb + bj * 128) = pack8(acc[ai][bj][m][0], acc[ai][bj][m][1]);
            }
    }
};
struct EpiRes {
    static constexpr bool AFTER_DRAIN = false;
    const float* res; float* out; float* stats; float alpha;
    __device__ __forceinline__ void operator()(const Acc& acc, const Unit& u, int wr, int wc, int fr, int fq) const {
        const int cb = u.pn * 256 + wc * 32 + 8 * fq;
#pragma unroll
        for (int ai = 0; ai < 2; ++ai)
#pragma unroll
            for (int m = 0; m < 4; ++m) {
                const int row = u.pm * 256 + ai * 128 + wr * 64 + m * 16 + fr;
                float s = 0.f, ss = 0.f;
#pragma unroll
                for (int bj = 0; bj < 2; ++bj) {
                    const size_t o = (size_t)row * DM + cb + bj * 128;
                    const f32x4 r0 = *(const f32x4*)(res + o), r1 = *(const f32x4*)(res + o + 4);
                    const f32x4 t0 = r0 * alpha + acc[ai][bj][m][0], t1 = r1 * alpha + acc[ai][bj][m][1];
#pragma unroll
                    for (int j = 0; j < 4; ++j) { s += t0[j] + t1[j]; ss += t0[j] * t0[j] + t1[j] * t1[j]; }
                    *(f32x4*)(out + o) = t0; *(f32x4*)(out + o + 4) = t1;
                }
                s += __shfl_xor(s, 16); s += __shfl_xor(s, 32); ss += __shfl_xor(ss, 16); ss += __shfl_xor(ss, 32);
                if (fq == 0) *(f32x2*)(stats + ((size_t)row * 32 + u.pn * 4 + wc) * 2) = (f32x2){s, ss};
            }
    }
};
template <bool RES_BF16> struct EpiResLn {
    static constexpr bool AFTER_DRAIN = true;
    const void* res; bf16_t* xb; const float* g; const float* b; unsigned char* ws; int layer, pad;
    static constexpr float alpha = 1.4142135623730951f;
    __device__ __forceinline__ void operator()(const Acc&, const Unit&, int, int, int, int) const {}
    __device__ __forceinline__ void fused(Acc& acc, const Unit& u, int wr, int wc, int fr, int fq, LAS unsigned char* lds, int wid, int lane) const {
        const int cb = u.pn * 256 + wc * 32 + 8 * fq;
        LAS f32x2* Pt = (LAS f32x2*)lds;
        LAS f32x2* St = (LAS f32x2*)(lds + 8192);
        unsigned long long* slots = (unsigned long long*)(ws + WS_SLOTS) + (size_t)layer * MTOK * 8; unsigned* cnt = (unsigned*)(ws + WS_CNT) + layer * 64 * 32;
#pragma unroll
        for (int ai = 0; ai < 2; ++ai) {
            const size_t ob = (size_t)(u.pm * 256 + ai * 128 + wr * 64 + fr) * DM + cb;
            f32x4 rr[4][2][2];
#pragma unroll
            for (int m = 0; m < 4; ++m)
#pragma unroll
                for (int bj = 0; bj < 2; ++bj) {
                    const size_t o = ob + (size_t)m * 16 * DM + bj * 128;
                    if constexpr (RES_BF16) { const u32x4 rw = *(const u32x4*)((const bf16_t*)res + o);
                        rr[m][bj][0] = (f32x4){bf_lo(rw.x), bf_hi(rw.x), bf_lo(rw.y), bf_hi(rw.y)}; rr[m][bj][1] = (f32x4){bf_lo(rw.z), bf_hi(rw.z), bf_lo(rw.w), bf_hi(rw.w)}; }
                    else { rr[m][bj][0] = *(const f32x4*)((const float*)res + o); rr[m][bj][1] = *(const f32x4*)((const float*)res + o + 4); }
                }
#pragma unroll
            for (int m = 0; m < 4; ++m) {
                const int rl = ai * 128 + wr * 64 + m * 16 + fr;
                float s = 0.f, ss = 0.f;
#pragma unroll
                for (int bj = 0; bj < 2; ++bj) {
                    const f32x4 t0 = rr[m][bj][0] * alpha + acc[ai][bj][m][0], t1 = rr[m][bj][1] * alpha + acc[ai][bj][m][1];
                    acc[ai][bj][m][0] = t0; acc[ai][bj][m][1] = t1;
#pragma unroll
                    for (int j = 0; j < 4; ++j) { s += t0[j] + t1[j]; ss += t0[j] * t0[j] + t1[j] * t1[j]; }
                }
                s += __shfl_xor(s, 16); s += __shfl_xor(s, 32); ss += __shfl_xor(ss, 16); ss += __shfl_xor(ss, 32);
                if (fq == 0) Pt[rl * 4 + wc] = (f32x2){s, ss};
            }
        }
        asm volatile("s_waitcnt lgkmcnt(0)" ::: "memory"); __builtin_amdgcn_s_barrier(); asm volatile("" ::: "memory");
        const int rowi = wid * 32 + (lane & 31);
        if (lane < 32) {
            const f32x2 a = Pt[rowi * 4 + 0], b2 = Pt[rowi * 4 + 1], c = Pt[rowi * 4 + 2], d = Pt[rowi * 4 + 3];
            const float S = (a.x + b2.x) + (c.x + d.x), SS = (a.y + b2.y) + (c.y + d.y);
            unsigned long long* slot = slots + ((size_t)(u.pm * 256 + rowi) * 8 + u.pn);
            __hip_atomic_store(slot, ((unsigned long long)__float_as_uint(SS) << 32) | __float_as_uint(S), __ATOMIC_RELAXED, __HIP_MEMORY_SCOPE_AGENT);
        }
        asm volatile("s_waitcnt vmcnt(0)" ::: "memory");
        if (lane == 0) __hip_atomic_fetch_add(cnt + 64 * u.pm, 1u, __ATOMIC_RELAXED, __HIP_MEMORY_SCOPE_AGENT);
        if (wid == 0) {
            unsigned sp = 0u;
            while ((unsigned)__builtin_amdgcn_readfirstlane(__hip_atomic_load(cnt + 64 * u.pm, __ATOMIC_RELAXED, __HIP_MEMORY_SCOPE_AGENT)) < 64u) { __builtin_amdgcn_s_sleep(2); if (++sp > (1u << 22)) break; }
            __builtin_amdgcn_fence(__ATOMIC_ACQUIRE, "agent");
        }
        asm volatile("s_waitcnt vmcnt(0) lgkmcnt(0)" ::: "memory"); __builtin_amdgcn_s_barrier(); asm volatile("" ::: "memory");
        if (lane < 32) {
            const unsigned long long* slot = slots + (size_t)(u.pm * 256 + rowi) * 8; float S = 0.f, SS = 0.f;
#pragma unroll
            for (int t = 0; t < 8; ++t) { const unsigned long long w = __hip_atomic_load(slot + t, __ATOMIC_RELAXED, __HIP_MEMORY_SCOPE_AGENT); S += __uint_as_float((unsigned)w); SS += __uint_as_float((unsigned)(w >> 32)); }
            const float mean = S * (1.0f / DM), var = SS * (1.0f / DM) - mean * mean;
            St[rowi] = (f32x2){mean, rsqrtf(var + 1e-5f)};
        }
        asm volatile("s_waitcnt lgkmcnt(0)" ::: "memory"); __builtin_amdgcn_s_barrier(); asm volatile("" ::: "memory");
#pragma unroll
        for (int bj = 0; bj < 2; ++bj) {
            const f32x4 g0 = *(const f32x4*)(g + cb + bj * 128), g1 = *(const f32x4*)(g + cb + bj * 128 + 4), b0 = *(const f32x4*)(b + cb + bj * 128), b1 = *(const f32x4*)(b + cb + bj * 128 + 4);
#pragma unroll
            for (int ai = 0; ai < 2; ++ai)
#pragma unroll
                for (int m = 0; m < 4; ++m) {
                    const int rl = ai * 128 + wr * 64 + m * 16 + fr;
                    const f32x2 st = St[rl];
                    const size_t o = (size_t)(u.pm * 256 + rl) * DM + cb + bj * 128;
                    const f32x4 o0 = (acc[ai][bj][m][0] - st.x) * st.y * g0 + b0, o1 = (acc[ai][bj][m][1] - st.x) * st.y * g1 + b1;
                    *(u32x4*)(xb + o) = pack8(o0, o1);
                }
        }
    }
};
template <bool OUT_F32> struct EpiPle {
    static constexpr bool AFTER_DRAIN = false;
    const bf16_t* xin; const bf16_t* pp; bf16_t* xb; float* outf;
    __device__ __forceinline__ void operator()(const Acc& acc, const Unit& u, int wr, int wc, int fr, int fq) const {
        const int cb = u.pn * 256 + wc * 32 + 8 * fq;
#pragma unroll
        for (int ai = 0; ai < 2; ++ai) {
            const size_t o0 = (size_t)(u.pm * 256 + ai * 128 + wr * 64 + fr) * DM + cb;
            u32x4 xw[4][2], pw[4][2];
#pragma unroll
            for (int m = 0; m < 4; ++m)
#pragma unroll
                for (int bj = 0; bj < 2; ++bj) { const size_t o = o0 + (size_t)m * 16 * DM + bj * 128; xw[m][bj] = *(const u32x4*)(xin + o); pw[m][bj] = *(const u32x4*)(pp + o); }
#pragma unroll
            for (int m = 0; m < 4; ++m)
#pragma unroll
                for (int bj = 0; bj < 2; ++bj) {
                    const size_t o = o0 + (size_t)m * 16 * DM + bj * 128;
                    const u32x4 x = xw[m][bj], p = pw[m][bj];
                    const f32x4 a0 = acc[ai][bj][m][0], a1 = acc[ai][bj][m][1];
                    f32x4 r0, r1;
                    r0[0] = bf_lo(x.x) + fast_sigmoid(a0[0]) * bf_lo(p.x); r0[1] = bf_hi(x.x) + fast_sigmoid(a0[1]) * bf_hi(p.x);
                    r0[2] = bf_lo(x.y) + fast_sigmoid(a0[2]) * bf_lo(p.y); r0[3] = bf_hi(x.y) + fast_sigmoid(a0[3]) * bf_hi(p.y);
                    r1[0] = bf_lo(x.z) + fast_sigmoid(a1[0]) * bf_lo(p.z); r1[1] = bf_hi(x.z) + fast_sigmoid(a1[1]) * bf_hi(p.z);
                    r1[2] = bf_lo(x.w) + fast_sigmoid(a1[2]) * bf_lo(p.w); r1[3] = bf_hi(x.w) + fast_sigmoid(a1[3]) * bf_hi(p.w);
                    if constexpr (OUT_F32) { *(f32x4*)(outf + o) = r0; *(f32x4*)(outf + o + 4) = r1; }
                    else *(u32x4*)(xb + o) = pack8(r0, r1);
                }
        }
    }
};
struct EpiL1In {
    static constexpr bool AFTER_DRAIN = false;
    bf16_t* Q; bf16_t* Kb; bf16_t* VT; bf16_t* Z; float* kpart;
    __device__ __forceinline__ void operator()(const Acc& acc, const Unit& u, int wr, int wc, int fr, int fq) const {
        const int type = u.pn >> 3, cb = (u.pn & 7) * 256 + wc * 32 + 8 * fq;
        if (type == 2) {
            const int b = u.pm >> 3, sb = (u.pm & 7) * 256 + wr * 64;
            const int pos = (fr < 4 || fr >= 12) ? fr : (fr < 8 ? fr + 4 : fr - 4);
#pragma unroll
            for (int bj = 0; bj < 2; ++bj)
#pragma unroll
                for (int n = 0; n < 2; ++n)
#pragma unroll
                    for (int j = 0; j < 4; ++j) {
                        const int c = cb + bj * 128 + 4 * n + j, h = c >> 7, d = c & 127;
                        bf16_t* base = VT + ((size_t)((b * 16 + h) * 128 + d)) * SEQ + sb + pos;
#pragma unroll
                        for (int ai = 0; ai < 2; ++ai)
#pragma unroll
                            for (int m = 0; m < 4; ++m) base[ai * 128 + m * 16] = (bf16_t)(cvt_pk_bf16(acc[ai][bj][m][n][j], 0.f) & 0xffffu);
                    }
            return;
        }
        bf16_t* O = Q + (size_t)type * (TT / 2);
        const float qs = 0.08838834764831845f * 1.4426950408889634f;
#pragma unroll
        for (int ai = 0; ai < 2; ++ai)
#pragma unroll
            for (int m = 0; m < 4; ++m) {
                const int row = u.pm * 256 + ai * 128 + wr * 64 + m * 16 + fr;
#pragma unroll
                for (int bj = 0; bj < 2; ++bj) {
                    f32x4 v0 = acc[ai][bj][m][0], v1 = acc[ai][bj][m][1];
                    if (type == 0) { v0 *= qs; v1 *= qs; }
                    if (type == 3) {
#pragma unroll
                        for (int j = 0; j < 4; ++j) { v0[j] = silu_f(v0[j]); v1[j] = silu_f(v1[j]); }
                    }
                    *(u32x4*)(O + (size_t)row * DM + cb + bj * 128) = pack8(v0, v1);
                }
            }
        if (type == 1) {
            float* kp = kpart + ((size_t)(u.pm * 2 + wr)) * DM;
#pragma unroll
            for (int bj = 0; bj < 2; ++bj)
#pragma unroll
                for (int n = 0; n < 2; ++n) {
                    f32x4 cs = (f32x4){0.f, 0.f, 0.f, 0.f};
#pragma unroll
                    for (int ai = 0; ai < 2; ++ai)
#pragma unroll
                        for (int m = 0; m < 4; ++m) cs += acc[ai][bj][m][n];
#pragma unroll
                    for (int j = 0; j < 4; ++j) { float v = cs[j]; v += __shfl_xor(v, 1); v += __shfl_xor(v, 2); v += __shfl_xor(v, 4); v += __shfl_xor(v, 8); cs[j] = v; }
                    if (fr == 0) *(f32x4*)(kp + cb + bj * 128 + 4 * n) = cs;
                }
        }
    }
};

template <bool REMAP = false>
__device__ __forceinline__ void transpose_convert(LAS unsigned char* lds, const float* src, bf16_t* dst, int K, int N, int G, int bid) {
    LAS float* tile = (LAS float*)lds;
    const int tid = threadIdx.x, ntn = N / 64, ntiles = (K / 128) * ntn;
    const int r0 = tid >> 4, c4 = tid & 15;
    f32x4 v[4];
    if (bid < ntiles) { const int k0 = (bid / ntn) * 128, n0 = (bid % ntn) * 64;
#pragma unroll
        for (int i = 0; i < 4; ++i) v[i] = __builtin_nontemporal_load((const f32x4*)(src + (size_t)(k0 + r0 + 32 * i) * N + n0 + c4 * 4)); }
    for (int t = bid; t < ntiles; t += G) {
        const int k0 = (t / ntn) * 128, n0 = (t % ntn) * 64;
        asm volatile("s_waitcnt lgkmcnt(0)" ::: "memory"); __builtin_amdgcn_s_barrier(); asm volatile("" ::: "memory");
#pragma unroll
        for (int i = 0; i < 4; ++i) {
#pragma unroll
            for (int j = 0; j < 4; ++j) tile[(r0 + 32 * i) * 65 + c4 * 4 + j] = v[i][j]; }
        asm volatile("s_waitcnt lgkmcnt(0)" ::: "memory"); __builtin_amdgcn_s_barrier(); asm volatile("" ::: "memory");
        if (t + G < ntiles) { const int k1 = ((t + G) / ntn) * 128, n1 = ((t + G) % ntn) * 64;
#pragma unroll
            for (int i = 0; i < 4; ++i) v[i] = __builtin_nontemporal_load((const f32x4*)(src + (size_t)(k1 + r0 + 32 * i) * N + n1 + c4 * 4)); }
#pragma unroll
        for (int i = 0; i < 2; ++i) { const int id = tid + 512 * i, n = id >> 4, kc = id & 15;
            float f[8];
#pragma unroll
            for (int j = 0; j < 8; ++j) f[j] = tile[(kc * 8 + j) * 65 + n];
            u32x4 w; w.x = cvt_pk_bf16(f[0], f[1]); w.y = cvt_pk_bf16(f[2], f[3]); w.z = cvt_pk_bf16(f[4], f[5]); w.w = cvt_pk_bf16(f[6], f[7]);
            const int nd = !REMAP ? n0 : (n0 < 2048 ? (n0 >> 7) * 256 + (n0 & 127) : (n0 < 4096 ? n0 + 2048 : ((n0 - 4096) >> 7) * 256 + 128 + (n0 & 127)));
            *(u32x4*)(dst + (size_t)(nd + n) * K + k0 + kc * 8) = w; }
    }
    __syncthreads();
}
__device__ __forceinline__ void convert_rows_xcd(const float* src, bf16_t* dst, int G, int bid) {
    const size_t per = (size_t)MTOK * DM / 8 / 8;
    const size_t base = (size_t)(bid & 7) * per, stride = (size_t)(G >> 3) * NTHREADS;
    for (size_t j = (size_t)(bid >> 3) * NTHREADS + threadIdx.x; j + 3 * stride < per + 3 * stride && j < per; j += 4 * stride) {
        f32x4 a[4], b[4];
#pragma unroll
        for (int u = 0; u < 4; ++u) { const size_t i = base + j + u * stride; if (j + u * stride < per) { a[u] = __builtin_nontemporal_load((const f32x4*)(src + i * 8)); b[u] = __builtin_nontemporal_load((const f32x4*)(src + i * 8 + 4)); } }
#pragma unroll
        for (int u = 0; u < 4; ++u) { const size_t i = base + j + u * stride; if (j + u * stride < per) *(u32x4*)(dst + i * 8) = pack8(a[u], b[u]); }
    }
}
__device__ __forceinline__ void convert_flat(const float* src, bf16_t* dst, size_t n, int G, int bid) {
    const size_t n8 = n / 8, stride = (size_t)G * NTHREADS;
    size_t i = (size_t)bid * NTHREADS + threadIdx.x;
    for (; i + 3 * stride < n8; i += 4 * stride) {
        f32x4 a[4], b[4];
#pragma unroll
        for (int u = 0; u < 4; ++u) { a[u] = __builtin_nontemporal_load((const f32x4*)(src + (i + u * stride) * 8)); b[u] = __builtin_nontemporal_load((const f32x4*)(src + (i + u * stride) * 8 + 4)); }
#pragma unroll
        for (int u = 0; u < 4; ++u) *(u32x4*)(dst + (i + u * stride) * 8) = pack8(a[u], b[u]);
    }
    for (; i < n8; i += stride) {
        const f32x4 a = __builtin_nontemporal_load((const f32x4*)(src + i * 8)), b = __builtin_nontemporal_load((const f32x4*)(src + i * 8 + 4));
        *(u32x4*)(dst + i * 8) = pack8(a, b);
    }
}

__device__ __forceinline__ void ln_apply_phase(float* xf, const float* stats, const float* g, const float* bta, bf16_t* xb, int G, int bid) {
    const int wid = threadIdx.x >> 6, lane = threadIdx.x & 63;
    for (int row = bid * 8 + wid; row < MTOK; row += G * 8) {
        float s = 0.f, ss = 0.f;
        if (lane < 32) { const f32x2 pr = *(const f32x2*)(stats + ((size_t)row * 32 + lane) * 2); s = pr.x; ss = pr.y; }
#pragma unroll
        for (int o = 32; o >= 1; o >>= 1) { s += __shfl_xor(s, o); ss += __shfl_xor(ss, o); }
        const float mean = s * (1.0f / DM), var = ss * (1.0f / DM) - mean * mean, rstd = rsqrtf(var + 1e-5f);
        float* xr = xf + (size_t)row * DM;
#pragma unroll
        for (int i = 0; i < 4; ++i) {
            const int c = i * 512 + lane * 8;
            const f32x4 t0 = *(const f32x4*)(xr + c), t1 = *(const f32x4*)(xr + c + 4);
            const f32x4 g0 = *(const f32x4*)(g + c), g1 = *(const f32x4*)(g + c + 4), b0 = *(const f32x4*)(bta + c), b1 = *(const f32x4*)(bta + c + 4);
            const f32x4 o0 = (t0 - mean) * rstd * g0 + b0, o1 = (t1 - mean) * rstd * g1 + b1;
            *(f32x4*)(xr + c) = o0; *(f32x4*)(xr + c + 4) = o1;
            *(u32x4*)(xb + (size_t)row * DM + c) = pack8(o0, o1);
        }
    }
}

__device__ __forceinline__ void sgu_phase(LAS unsigned char* lds, const bf16_t* U, const bf16_t* GV, const bf16_t* SZ, const float* stats, const float* vg, const float* vb,
                                          const bf16_t* wsb, const float* b_s, bf16_t* Y, int G, int bid) {
    constexpr int VST = 272;
    LAS unsigned char* vnT = lds;
    LAS f32x2* rstat = (LAS f32x2*)(lds + 128 * VST);
    const int tid = threadIdx.x, wid = tid >> 6, lane = tid & 63, fr = lane & 15, fq = lane >> 4;
    const bool xmap = (G == 256);
    for (int itl = bid; itl < 1024; itl += G) {
        const int it = xmap ? ((bid & 7) * 128 + (bid >> 3) + 32 * (itl >> 8)) : itl;
        const int ci = it >> 4, g = it & 15, row0 = ci * 128;
        __syncthreads();
        if (tid < 128) {
            const float* sp = stats + (size_t)(row0 + tid) * 64; float s = 0.f, ss = 0.f;
#pragma unroll
            for (int i = 0; i < 16; ++i) { const f32x4 q = *(const f32x4*)(sp + i * 4); s += q[0] + q[2]; ss += q[1] + q[3]; }
            const float mean = s * (1.0f / DM), var = ss * (1.0f / DM) - mean * mean;
            rstat[tid] = (f32x2){mean, rsqrtf(var + 1e-5f)};
        }
        __syncthreads();
#pragma unroll
        for (int i = 0; i < 4; ++i) {
            const int id = tid + 512 * i, r = id >> 4, cc = id & 15;
            const u32x4 w = *(const u32x4*)(GV + (size_t)(row0 + r) * DM + g * 128 + cc * 8);
            const f32x2 st = rstat[r];
            const f32x4 g0 = *(const f32x4*)(vg + g * 128 + cc * 8), g1 = *(const f32x4*)(vg + g * 128 + cc * 8 + 4);
            const f32x4 b0 = *(const f32x4*)(vb + g * 128 + cc * 8), b1 = *(const f32x4*)(vb + g * 128 + cc * 8 + 4);
            float f[8] = {bf_lo(w.x), bf_hi(w.x), bf_lo(w.y), bf_hi(w.y), bf_lo(w.z), bf_hi(w.z), bf_lo(w.w), bf_hi(w.w)};
#pragma unroll
            for (int j = 0; j < 8; ++j) {
                const float gg = j < 4 ? g0[j & 3] : g1[j & 3], bb = j < 4 ? b0[j & 3] : b1[j & 3];
                const float vn = (f[j] - st.x) * st.y * gg + bb;
                *(LAS bf16_t*)(vnT + (cc * 8 + j) * VST + (((r >> 3) ^ cc) << 4) + (r & 7) * 2) = (bf16_t)(cvt_pk_bf16(vn, 0.f) & 0xffffu);
            }
        }
        __syncthreads();
        f32x4 acc[8];
#pragma unroll
        for (int ct = 0; ct < 8; ++ct) acc[ct] = (f32x4){0.f, 0.f, 0.f, 0.f};
        const bf16_t* wrow = wsb + ((size_t)g * 128 + wid * 16 + fr) * 128 + fq * 8;
        const int nks = (wid >> 1) + 1;
        for (int ks = 0; ks < nks; ++ks) {
            const bf16x8 wf = *(const bf16x8*)(wrow + ks * 32);
#pragma unroll
            for (int ct = 0; ct < 8; ++ct) {
                const bf16x8 vf = *(const LAS bf16x8*)(vnT + (ct * 16 + fr) * VST + (((ks * 4 + fq) ^ (ct * 2 + (fr >> 3))) << 4));
                acc[ct] = __builtin_amdgcn_mfma_f32_16x16x32_bf16(vf, wf, acc[ct], 0, 0, 0);
            }
        }
        const int t = wid * 16 + fr; const float bs = b_s[g * 128 + t];
        const size_t ro = (size_t)(row0 + t) * DM + g * 128 + 4 * fq;
#pragma unroll
        for (int ct = 0; ct < 8; ++ct) {
            const u32x2 uw = *(const u32x2*)(U + ro + ct * 16);
            const float y0 = bf_lo(uw.x) * (acc[ct][0] + bs), y1 = bf_hi(uw.x) * (acc[ct][1] + bs);
            const float y2 = bf_lo(uw.y) * (acc[ct][2] + bs), y3 = bf_hi(uw.y) * (acc[ct][3] + bs);
            u32x2 o; o.x = cvt_pk_bf16(y0, y1); o.y = cvt_pk_bf16(y2, y3);
            *(u32x2*)(Y + ro + ct * 16) = o;
        }
    }
    __syncthreads();
}

#define MFMA32(a, b, c) __builtin_amdgcn_mfma_f32_32x32x16_bf16((a), (b), (c), 0, 0, 0)
__device__ __forceinline__ void attn_phase(LAS unsigned char* lds, const bf16_t* Q, const bf16_t* Kb, const bf16_t* VT, const bf16_t* Z, const float* kpart, bf16_t* Y, int G, int bid) {
    constexpr int KST = 272, VSTR = 144, KBUF = 64 * KST, VBUF = 128 * VSTR;
    const int tid = threadIdx.x, wid = __builtin_amdgcn_readfirstlane(tid >> 6), lane = tid & 63, qr = lane & 31, hh = lane >> 5;
    const float NEG = -__builtin_inff();
    for (int pair = bid; pair < 256; pair += G) {
        const int bh = pair >> 2, jp = pair & 3, b = bh >> 4, h = bh & 15;
        for (int half = 0; half < 2; ++half) {
            const int own = half == 0 ? 7 - jp : jp;
            const int q0 = own * 256 + wid * 32;
            const size_t qoff = (size_t)(b * SEQ + q0 + qr) * DM + h * 128;
            bf16x8 Qf[8];
#pragma unroll
            for (int ks = 0; ks < 8; ++ks) Qf[ks] = *(const bf16x8*)(Q + qoff + ks * 16 + hh * 8);
            unsigned selmask = (1u << own) - 1u;
            if (own > 3) {
                f32x16 gacc;
#pragma unroll
                for (int j = 0; j < 16; ++j) gacc[j] = 0.f;
#pragma unroll
                for (int ks = 0; ks < 8; ++ks) {
                    u32x4 w = (u32x4){0u, 0u, 0u, 0u};
                    if (qr < 8) {
                        const float* kp = kpart + ((size_t)((b * 8 + qr) * 2)) * DM + h * 128 + ks * 16 + hh * 8;
                        const f32x4 a0 = *(const f32x4*)(kp), a1 = *(const f32x4*)(kp + 4), c0 = *(const f32x4*)(kp + DM), c1 = *(const f32x4*)(kp + DM + 4);
                        w = pack8((a0 + c0) * (1.0f / 256.0f), (a1 + c1) * (1.0f / 256.0f));
                    }
                    bf16x8 af; __builtin_memcpy(&af, &w, 16);
                    gacc = MFMA32(af, Qf[ks], gacc);
                }
                float gt[8];
#pragma unroll
                for (int j = 0; j < 4; ++j) { const float mine = gacc[j], oth = __shfl_xor(mine, 32); gt[j] = hh == 0 ? mine : oth; gt[4 + j] = hh == 0 ? oth : mine; }
#pragma unroll
                for (int j = 0; j < 8; ++j) if (j >= own) gt[j] = NEG;
                selmask = 0u;
#pragma unroll
                for (int r = 0; r < 3; ++r) {
                    float best = NEG; unsigned bi = 0u;
#pragma unroll
                    for (int j = 0; j < 8; ++j) { const bool take = !((selmask >> j) & 1u) && gt[j] > best; best = take ? gt[j] : best; bi = take ? (unsigned)j : bi; }
                    selmask |= 1u << bi;
                }
            }
            f32x16 O[4];
#pragma unroll
            for (int dt = 0; dt < 4; ++dt)
#pragma unroll
                for (int j = 0; j < 16; ++j) O[dt][j] = 0.f;
            float mrow = NEG, lsum = 0.f;
            const int ntile = (own + 1) * 4;
            const bf16_t* kg = Kb + (size_t)(b * SEQ) * DM + h * 128;
            const bf16_t* vg = VT + (size_t)((b * 16 + h) * 128) * SEQ;
            u32x4 kreg[2], vreg[2];
#define ATT_LOAD(i_) do { const int _i = (i_); const int _kt = _i < 4 ? own * 4 + _i : _i - 4; \
                _Pragma("unroll") for (int c2 = 0; c2 < 2; ++c2) { const int id = tid + 512 * c2; \
                    kreg[c2] = *(const u32x4*)(kg + (size_t)(_kt * 64 + (id >> 4)) * DM + (id & 15) * 8); \
                    vreg[c2] = *(const u32x4*)(vg + (size_t)(id >> 3) * SEQ + _kt * 64 + (id & 7) * 8); } } while (0)
#define ATT_STORE(buf_) do { _Pragma("unroll") for (int c2 = 0; c2 < 2; ++c2) { const int id = tid + 512 * c2; \
                    *(LAS u32x4*)(lds + (buf_) * KBUF + (id >> 4) * KST + (id & 15) * 16) = kreg[c2]; \
                    *(LAS u32x4*)(lds + 2 * KBUF + (buf_) * VBUF + (id >> 3) * VSTR + (id & 7) * 16) = vreg[c2]; } } while (0)
            ATT_LOAD(0);
            __syncthreads();
            ATT_STORE(0);
            ATT_LOAD(1);
            __syncthreads();
            for (int i = 0; i < ntile; ++i) {
                const int kt = i < 4 ? own * 4 + i : i - 4, buf = i & 1;
                const bool is_own = i < 4;
                const bool skip = is_own && (kt * 64 > q0 + 31);
                if (!skip) {
                    const LAS unsigned char* kb_ = lds + buf * KBUF;
                    const LAS unsigned char* vb_ = lds + 2 * KBUF + buf * VBUF;
                    f32x16 s0, s1;
                    const float sinit = (i == 0) ? 0.f : ((is_own || ((selmask >> (kt >> 2)) & 1u)) ? -mrow : -1.0e30f);
#pragma unroll
                    for (int j = 0; j < 16; ++j) { s0[j] = sinit; s1[j] = sinit; }
                    {
                        const LAS unsigned char* kp0 = kb_ + qr * KST + hh * 16; const LAS unsigned char* kp1 = kp0 + 32 * KST;
                        bf16x8 k0a = *(const LAS bf16x8*)(kp0), k0c = *(const LAS bf16x8*)(kp1);
                        bf16x8 k1a = *(const LAS bf16x8*)(kp0 + 32), k1c = *(const LAS bf16x8*)(kp1 + 32);
                        bf16x8 k2a = *(const LAS bf16x8*)(kp0 + 64), k2c = *(const LAS bf16x8*)(kp1 + 64);
#pragma unroll
                        for (int ks = 0; ks < 8; ++ks) {
                            bf16x8 na = k2a, nc = k2c;
                            if (ks < 5) { na = *(const LAS bf16x8*)(kp0 + (ks + 3) * 32); nc = *(const LAS bf16x8*)(kp1 + (ks + 3) * 32); }
                            __builtin_amdgcn_sched_barrier(0);
                            s0 = MFMA32(k0a, Qf[ks], s0); s1 = MFMA32(k0c, Qf[ks], s1);
                            __builtin_amdgcn_sched_barrier(0);
                            k0a = k1a; k0c = k1c; k1a = k2a; k1c = k2c; k2a = na; k2c = nc;
                        }
                    }
                    if (is_own) {
                        if (kt * 64 + 63 > q0) {
                            const int qpos = q0 + qr, kb0 = kt * 64 + hh * 4;
#pragma unroll
                            for (int j = 0; j < 16; ++j) { const int key = kb0 + (j >> 2) * 8 + (j & 3); if (key > qpos) s0[j] = NEG; if (key + 32 > qpos) s1[j] = NEG; }
                        }
                    }
                    if (i == 0) {
                        float mx = s0[0];
#pragma unroll
                        for (int j = 1; j < 16; ++j) mx = fmaxf(mx, s0[j]);
#pragma unroll
                        for (int j = 0; j < 16; ++j) mx = fmaxf(mx, s1[j]);
                        mx = fmaxf(mx, __shfl_xor(mx, 32));
                        mrow = mx;
#pragma unroll
                        for (int j = 0; j < 16; ++j) { s0[j] -= mx; s1[j] -= mx; }
                    }
                    __builtin_amdgcn_s_setprio(1);
                    float ps = 0.f;
#pragma unroll
                    for (int j = 0; j < 16; ++j) { s0[j] = __builtin_amdgcn_exp2f(s0[j]); s1[j] = __builtin_amdgcn_exp2f(s1[j]); ps += s0[j] + s1[j]; }
                    lsum += ps;
                    bf16x8 P[4];
                    { u32x4 w;
                      w.x = cvt_pk_bf16_t(s0[0], s0[1]); w.y = cvt_pk_bf16_t(s0[2], s0[3]); w.z = cvt_pk_bf16_t(s0[4], s0[5]); w.w = cvt_pk_bf16_t(s0[6], s0[7]); __builtin_memcpy(&P[0], &w, 16);
                      w.x = cvt_pk_bf16_t(s0[8], s0[9]); w.y = cvt_pk_bf16_t(s0[10], s0[11]); w.z = cvt_pk_bf16_t(s0[12], s0[13]); w.w = cvt_pk_bf16_t(s0[14], s0[15]); __builtin_memcpy(&P[1], &w, 16);
                      w.x = cvt_pk_bf16_t(s1[0], s1[1]); w.y = cvt_pk_bf16_t(s1[2], s1[3]); w.z = cvt_pk_bf16_t(s1[4], s1[5]); w.w = cvt_pk_bf16_t(s1[6], s1[7]); __builtin_memcpy(&P[2], &w, 16);
                      w.x = cvt_pk_bf16_t(s1[8], s1[9]); w.y = cvt_pk_bf16_t(s1[10], s1[11]); w.z = cvt_pk_bf16_t(s1[12], s1[13]); w.w = cvt_pk_bf16_t(s1[14], s1[15]); __builtin_memcpy(&P[3], &w, 16); }
                    __builtin_amdgcn_s_setprio(0);
                    {
                        const LAS unsigned char* vp = vb_ + qr * VSTR + hh * 16;
#define ATT_VADDR(st_, half_) (vp + (((st_) >> 2)) * 32 * VSTR + (((st_) & 3) + (half_)) * 32)
                        bf16x8 v0a = *(const LAS bf16x8*)ATT_VADDR(0, 0), v0c = *(const LAS bf16x8*)ATT_VADDR(0, 1);
                        bf16x8 v1a = *(const LAS bf16x8*)ATT_VADDR(2, 0), v1c = *(const LAS bf16x8*)ATT_VADDR(2, 1);
                        bf16x8 v2a = *(const LAS bf16x8*)ATT_VADDR(4, 0), v2c = *(const LAS bf16x8*)ATT_VADDR(4, 1);
#pragma unroll
                        for (int st = 0; st < 16; st += 2) {
                            const int dt = st >> 2, kk = st & 3;
                            bf16x8 na = v2a, nc = v2c;
                            if (st < 10) { na = *(const LAS bf16x8*)ATT_VADDR(st + 6, 0); nc = *(const LAS bf16x8*)ATT_VADDR(st + 6, 1); }
                            __builtin_amdgcn_sched_barrier(0);
                            O[dt] = MFMA32(v0a, P[kk], O[dt]); O[dt] = MFMA32(v0c, P[kk + 1], O[dt]);
                            __builtin_amdgcn_sched_barrier(0);
                            v0a = v1a; v0c = v1c; v1a = v2a; v1c = v2c; v2a = na; v2c = nc;
                        }
#undef ATT_VADDR
                    }
                }
                if (i + 1 < ntile) ATT_STORE((i + 1) & 1);
                asm volatile("s_waitcnt lgkmcnt(0)" ::: "memory"); __builtin_amdgcn_s_barrier(); asm volatile("" ::: "memory");
                if (i + 2 < ntile) ATT_LOAD(i + 2);
            }
#undef ATT_LOAD
#undef ATT_STORE
            const float ltot = lsum + __shfl_xor(lsum, 32), inv = 1.0f / ltot;
#pragma unroll
            for (int dt = 0; dt < 4; ++dt)
#pragma unroll
                for (int i4 = 0; i4 < 4; ++i4) {
                    const size_t o = qoff + dt * 32 + i4 * 8 + hh * 4;
                    const u32x2 zw = *(const u32x2*)(Z + o);
                    u32x2 ow;
                    ow.x = cvt_pk_bf16(O[dt][4 * i4 + 0] * inv * bf_lo(zw.x), O[dt][4 * i4 + 1] * inv * bf_hi(zw.x));
                    ow.y = cvt_pk_bf16(O[dt][4 * i4 + 2] * inv * bf_lo(zw.y), O[dt][4 * i4 + 3] * inv * bf_hi(zw.y));
                    *(u32x2*)(Y + o) = ow;
                }
        }
    }
    __syncthreads();
}


#define XB_TMO      128
#define XB_XCNT(j)  (256  + 64 * (j))
#define XB_XSUB(j)  (1280 + 64 * (j))
#define XB_XGEN(j)  (2304 + 64 * (j))
#define XB_TOP      3328
#define XB_TOPGEN   3392
#define XCD_BAR_WORDS 3456
#define XB_SPIN_CAP (1u << 18)
__device__ __forceinline__ unsigned xb_ld(unsigned* p)              { return __hip_atomic_load(p, __ATOMIC_RELAXED, __HIP_MEMORY_SCOPE_AGENT); }
__device__ __forceinline__ unsigned xb_add(unsigned* p, unsigned v) { return __hip_atomic_fetch_add(p, v, __ATOMIC_RELAXED, __HIP_MEMORY_SCOPE_AGENT); }
__device__ __forceinline__ unsigned xb_xcc_id() { return (unsigned)__builtin_amdgcn_s_getreg((3 << 11) | 20) & 0xFu; }
#define XB_SPIN(cond, bar) do { unsigned _sp = 0; while (cond) { __builtin_amdgcn_s_sleep(1); \
    if ((++_sp & 255u) == 0u) { if (xb_ld(&(bar)[XB_TMO])) break; if (_sp > XB_SPIN_CAP) { atomicAdd(&(bar)[XB_TMO], 1u); break; } } } } while (0)
struct XcdBarrier { unsigned* bar; unsigned x; volatile LAS unsigned* st; };
__device__ __forceinline__ XcdBarrier xcd_barrier_post(unsigned* bar, volatile LAS unsigned* st) {
    XcdBarrier b; b.bar = bar; b.x = xb_xcc_id(); b.st = st;
    if (threadIdx.x == 0) (void)xb_add(&bar[XB_XCNT(b.x)], 1u);
    return b;
}
__device__ __forceinline__ void xcd_barrier_complete(unsigned* bar, unsigned x, unsigned& nloc, unsigned& nx) {
    const unsigned G = gridDim.x * gridDim.y * gridDim.z;
    unsigned sum, cnt, mine, sp = 0u;
    for (;;) {
        sum = 0u; cnt = 0u; mine = 0u;
#pragma unroll
        for (unsigned j = 0; j < 16; ++j) { const unsigned c = xb_ld(&bar[XB_XCNT(j)]); sum += c; cnt += (c > 0u) ? 1u : 0u; mine = (j == x) ? c : mine; }
        if (sum == G) break;
        __builtin_amdgcn_s_sleep(1);
        if ((++sp & 255u) == 0u) { if (xb_ld(&bar[XB_TMO])) break; if (sp > XB_SPIN_CAP) { atomicAdd(&bar[XB_TMO], 1u); break; } }
    }
    nloc = mine > 0u ? mine : 1u; nx = cnt > 0u ? cnt : 1u;
}
__device__ __forceinline__ void xcd_barrier(const XcdBarrier& b) {
    asm volatile("s_waitcnt vmcnt(0)" ::: "memory");
    __syncthreads();
    if (threadIdx.x == 0) {
        unsigned* bar = b.bar;
        __builtin_amdgcn_s_waitcnt(0);
        unsigned nloc = b.st[0], nx = b.st[1];
        if (nloc == 0u) { xcd_barrier_complete(bar, b.x, nloc, nx); b.st[0] = nloc; b.st[1] = nx; }
        const unsigned old = xb_add(&bar[XB_XSUB(b.x)], 1u);
        const unsigned gen = old / nloc;
        if (old + 1u == (gen + 1u) * nloc) {
            __builtin_amdgcn_fence(__ATOMIC_RELEASE, "agent");
            asm volatile("s_waitcnt vmcnt(0)" ::: "memory");
            const unsigned og = xb_add(&bar[XB_TOP], 1u);
            const unsigned tg = og / nx;
            if (og + 1u == (tg + 1u) * nx) xb_add(&bar[XB_TOPGEN], 1u);
            else XB_SPIN(xb_ld(&bar[XB_TOPGEN]) == tg, bar);
            __builtin_amdgcn_fence(__ATOMIC_ACQUIRE, "agent");
            xb_add(&bar[XB_XGEN(b.x)], 1u);
            asm volatile("s_waitcnt vmcnt(0)" ::: "memory");
        } else {
            XB_SPIN(xb_ld(&bar[XB_XGEN(b.x)]) == gen, bar);
            __builtin_amdgcn_fence(__ATOMIC_ACQUIRE, "agent");
            asm volatile("s_waitcnt vmcnt(0)" ::: "memory");
        }
    }
    __syncthreads();
}

constexpr int NPHASE = 11;
__global__ void __launch_bounds__(NTHREADS, 2) mk_fwd(Params P) {
    extern __shared__ __attribute__((aligned(16))) unsigned char lds_raw[];
    LAS unsigned char* lds = (LAS unsigned char*)lds_raw;
    cg::grid_group grid = cg::this_grid();
    const int G = gridDim.x, bid = blockIdx.x, lo = P.lo, hi = P.hi;
    unsigned char* ws = P.ws;
    bf16_t* WINB = (bf16_t*)(ws + WS_WINB); bf16_t* WOUT1 = (bf16_t*)(ws + WS_WOUT1); bf16_t* WG1 = (bf16_t*)(ws + WS_WG1); bf16_t* WP = (bf16_t*)(ws + WS_WP);
    bf16_t* PB = (bf16_t*)(ws + WS_PB); float* STATS = (float*)(ws + WS_STATS); float* KPART = (float*)(ws + WS_KPART); bf16_t* WSB = (bf16_t*)(ws + WS_WSB);
    bf16_t* SLOTA = (bf16_t*)(ws + WS_SLOTA); bf16_t* WINA = (bf16_t*)(ws + WS_WINA); bf16_t* WOUT0 = (bf16_t*)(ws + WS_WOUT0); bf16_t* WG0 = (bf16_t*)(ws + WS_WG0);
    bf16_t* Ub = (bf16_t*)(ws + WS_U); bf16_t* GVb = (bf16_t*)(ws + WS_GV); bf16_t* SZb = (bf16_t*)(ws + WS_SZ);
    bf16_t* Qb = (bf16_t*)(ws + WS_Q); bf16_t* Kb = (bf16_t*)(ws + WS_K); bf16_t* VTb = (bf16_t*)(ws + WS_VT); bf16_t* Zb = (bf16_t*)(ws + WS_Z);
    bf16_t* PP0 = (bf16_t*)(ws + WS_PP0); bf16_t* PP1 = (bf16_t*)(ws + WS_PP1); bf16_t* X1B = (bf16_t*)(ws + WS_X1B); bf16_t* X3B = (bf16_t*)(ws + WS_X3B); bf16_t* Y1 = (bf16_t*)P.out;
    const float ALPHA = 1.4142135623730951f;
#define IN(k) (lo <= (k) && (k) < hi)
    volatile LAS unsigned* xst = (volatile LAS unsigned*)(lds + LDS_MAIN);
    if (threadIdx.x == 0) { xst[0] = 0u; xst[1] = 0u; }
    __syncthreads();
    XcdBarrier xbar; xbar.bar = (unsigned*)(ws + WS_BAR); xbar.x = 0; xbar.st = xst;
    if (hi - lo > 1) xbar = xcd_barrier_post((unsigned*)(ws + WS_BAR), xst);
    if (hi > NPHASE) grid.sync();
#define SEAM(k) do { if (IN(k) && hi > (k) + 1) xcd_barrier(xbar); } while (0)

    if (IN(0)) {
        transpose_convert(lds, P.w_in_b, WINB, 2048, 8192, G, bid);
        transpose_convert(lds, P.w_out, WOUT0, 2048, 2048, G, bid);
        transpose_convert(lds, P.w_out + (size_t)2048 * 2048, WOUT1, 2048, 2048, G, bid);
        transpose_convert(lds, P.w_gate, WG0, 2048, 2048, G, bid);
        transpose_convert(lds, P.w_gate + (size_t)2048 * 2048, WG1, 2048, 2048, G, bid);
        transpose_convert(lds, P.w_proj, WP, 256, 2048, G, bid);
        transpose_convert(lds, P.w_proj + (size_t)256 * 2048, WP + (size_t)2048 * 256, 256, 2048, G, bid);
        convert_flat(P.p, PB, (size_t)2 * MTOK * 256, G, bid);
        for (int i = bid * NTHREADS + threadIdx.x; i < 16 * 128 * 128; i += G * NTHREADS) { const int s = i & 127, t = (i >> 7) & 127; WSB[i] = (bf16_t)(cvt_pk_bf16(s <= t ? P.w_s[i] : 0.f, 0.f) & 0xffffu); }
        transpose_convert<true>(lds, P.w_in_a, WINA, 2048, 6144, G, bid);
        if (G == 256) convert_rows_xcd(P.x, SLOTA, G, bid); else convert_flat(P.x, SLOTA, (size_t)MTOK * DM, G, bid);
    }
    SEAM(0);
    if (IN(1)) {
        pg8::Gemm g{SLOTA, WINA, MTOK, 6144, 2048, 1 << 30, 0}; pg8::StaticOrder S; S.init(MTOK, 6144, G, bid);
        EpiL0In E{Ub, GVb, STATS};
        pg8::gemm_phase<EpiL0In, true>(lds, g, S, E);
    }
    SEAM(1);
    if (IN(2)) sgu_phase(lds, Ub, GVb, SZb, STATS, P.sgu_g, P.sgu_b, WSB, P.b_s, Y1, G, bid);
    SEAM(2);
    if (IN(3)) {
        { pg8::Gemm g{PB, WP, 2 * MTOK, 2048, 256, 32, 8}; pg8::StaticOrder S; S.init(2 * MTOK, 2048, G, bid);
          EpiPlain E{PP0, (long long)((WS_PP1 - WS_PP0) / 2)}; pg8::gemm_phase(lds, g, S, E); }
        { pg8::Gemm g{Y1, WOUT0, MTOK, 2048, 2048, 1 << 30, 0}; pg8::StaticOrder S; S.init(MTOK, 2048, G, bid);
          EpiResLn<true> E{SLOTA, X1B, P.ln_g, P.ln_b, ws, 0, 0}; pg8::gemm_phase(lds, g, S, E); }
    }
    SEAM(3);
    if (IN(5)) {
        pg8::Gemm g{X1B, WG0, MTOK, 2048, 2048, 1 << 30, 0}; pg8::StaticOrder S; S.init(MTOK, 2048, G, bid);
        EpiPle<false> E{X1B, PP0, SLOTA, nullptr}; pg8::gemm_phase<EpiPle<false>, true>(lds, g, S, E);
    }
    SEAM(5);
    if (IN(6)) {
        pg8::Gemm g{SLOTA, WINB, MTOK, 8192, 2048, 1 << 30, 0}; pg8::StaticOrder S; S.init(MTOK, 8192, G, bid);
        EpiL1In E{Qb, Kb, VTb, Zb, KPART}; pg8::gemm_phase<EpiL1In, true>(lds, g, S, E);
    }
    SEAM(6);
    if (IN(7)) attn_phase(lds, Qb, Kb, VTb, Zb, KPART, Y1, G, bid);
    SEAM(7);
    if (IN(8)) {
        { pg8::Gemm g{Y1, WOUT1, MTOK, 2048, 2048, 1 << 30, 0}; pg8::StaticOrder S; S.init(MTOK, 2048, G, bid);
          EpiResLn<true> E{SLOTA, X3B, P.ln_g + DM, P.ln_b + DM, ws, 1, 0}; pg8::gemm_phase(lds, g, S, E); }
    }
    SEAM(8);
    if (IN(10)) {
        pg8::Gemm g{X3B, WG1, MTOK, 2048, 2048, 1 << 30, 0}; pg8::StaticOrder S; S.init(MTOK, 2048, G, bid);
        EpiPle<true> E{X3B, PP1, nullptr, P.out}; pg8::gemm_phase<EpiPle<true>, true>(lds, g, S, E);
    }
#undef IN
#undef SEAM
}

extern "C" void kernel_launch(void* const* d_in, const int* in_sizes, int n_in, void* d_out, int out_size, void* d_ws, size_t ws_size, hipStream_t stream) {
    static int grid_blocks = 0;
    if (grid_blocks == 0) {
        if (n_in != 13 || out_size != MTOK * DM || ws_size < WS_END) { fprintf(stderr, "kernel_launch: unexpected shapes (n_in %d out %d ws %zu)\n", n_in, out_size, ws_size); grid_blocks = -1; return; }
        int dev = 0, cus = 0, per_cu = 0;
        hipGetDevice(&dev);
        hipDeviceGetAttribute(&cus, hipDeviceAttributeMultiprocessorCount, dev);
        if (hipFuncSetAttribute((const void*)mk_fwd, hipFuncAttributeMaxDynamicSharedMemorySize, LDS_BYTES) != hipSuccess) { fprintf(stderr, "kernel_launch: hipFuncSetAttribute failed\n"); grid_blocks = -1; return; }
        if (hipOccupancyMaxActiveBlocksPerMultiprocessor(&per_cu, (const void*)mk_fwd, NTHREADS, LDS_BYTES) != hipSuccess || per_cu < 1) { fprintf(stderr, "kernel_launch: occupancy query failed (%d)\n", per_cu); grid_blocks = -1; return; }
        grid_blocks = cus;
    }
    if (grid_blocks < 0) return;
    if (hipMemsetAsync((unsigned char*)d_ws + WS_BAR, 0, 16384 + 32768, stream) != hipSuccess) { fprintf(stderr, "kernel_launch: memset of the barrier words failed\n"); return; }
    Params p{};
    p.x = (const float*)d_in[0]; p.p = (const float*)d_in[1]; p.w_in_a = (const float*)d_in[2]; p.sgu_g = (const float*)d_in[3]; p.sgu_b = (const float*)d_in[4];
    p.w_s = (const float*)d_in[5]; p.b_s = (const float*)d_in[6]; p.w_in_b = (const float*)d_in[7]; p.w_out = (const float*)d_in[8]; p.ln_g = (const float*)d_in[9];
    p.ln_b = (const float*)d_in[10]; p.w_gate = (const float*)d_in[11]; p.w_proj = (const float*)d_in[12];
    p.out = (float*)d_out; p.ws = (unsigned char*)d_ws;
#if ONE_LAUNCH
    p.lo = 0; p.hi = NPHASE;
    void* args[] = {&p};
    hipError_t e = hipLaunchCooperativeKernel((const void*)mk_fwd, dim3(grid_blocks), dim3(NTHREADS), args, LDS_BYTES, stream);
    if (e != hipSuccess) fprintf(stderr, "cooperative launch failed: %s (grid %d)\n", hipGetErrorString(e), grid_blocks);
#else
    for (int k = 0; k < NPHASE; ++k) {
        p.lo = k; p.hi = k + 1;
        hipLaunchKernelGGL(mk_fwd, dim3(grid_blocks), dim3(NTHREADS), LDS_BYTES, stream, p);
    }
#endif
}
```
